# Optimizing an MI355X kernel written in HIP

```python
import jax, jax.numpy as jnp
from jax import lax
import numpy as np

D_MODEL = 1024
BATCH = 8
SEQ = 4096
DEPTH = 1

GLA_HEADS = 4
GLA_DK = 128
GLA_DV = 256
GLA_QK_W = GLA_HEADS * GLA_DK
GLA_V_W = GLA_HEADS * GLA_DV
GATE_RANK = 16
GATE_NORM = 16.0
CHUNK = 64
CONV_W = 1024
CONV_WIDTH = 3
MIX_W = GLA_V_W + CONV_W
SPLITS = [GLA_QK_W, GLA_QK_W, GLA_V_W, GLA_V_W, GATE_RANK, GATE_RANK,
          CONV_W, CONV_W, CONV_W, CONV_W]
IN_W = sum(SPLITS)
EPS = 1e-6

kernel_name = "hybrid_gla_shortconv_parallel_heads"


def rmsnorm(x, g):
    xf = x.astype(jnp.float32)
    y = xf * lax.rsqrt(jnp.mean(xf * xf, axis=-1, keepdims=True) + EPS)
    return (y * g.astype(jnp.float32)).astype(x.dtype)


def gla_direction(q, k, v, g, strict):
    bsz, nh, s, dk = q.shape
    dv = v.shape[-1]
    n = s // CHUNK
    q = q.reshape(bsz, nh, n, CHUNK, dk)
    k = k.reshape(bsz, nh, n, CHUNK, dk)
    v = v.reshape(bsz, nh, n, CHUNK, dv)
    g = g.reshape(bsz, nh, n, CHUNK, dk)
    b = jnp.cumsum(g, axis=3)
    b_ref = b[:, :, :, CHUNK // 2:CHUNK // 2 + 1, :]
    att = jnp.einsum('bhncd,bhnjd->bhncj', q * jnp.exp(b - b_ref), k * jnp.exp(b_ref - b))
    mask = jnp.tril(jnp.ones((CHUNK, CHUNK), dtype=bool), k=-1 if strict else 0)
    att = jnp.where(mask, att, 0.0)
    o_intra = jnp.einsum('bhncj,bhnjv->bhncv', att, v)
    b_last = b[:, :, :, -1:, :]
    q_in = q * jnp.exp(b)
    k_out = k * jnp.exp(b_last - b)
    decay_chunk = jnp.exp(b_last[:, :, :, 0, :])
    xs = (jnp.moveaxis(q_in, 2, 0), jnp.moveaxis(k_out, 2, 0),
          jnp.moveaxis(v, 2, 0), jnp.moveaxis(decay_chunk, 2, 0))

    def step(state, inp):
        qc, kc, vc, dc = inp
        o = jnp.einsum('bhcd,bhdv->bhcv', qc, state)
        state = dc[..., None] * state + jnp.einsum('bhcd,bhcv->bhdv', kc, vc)
        return state, o

    s0 = jnp.zeros((bsz, nh, dk, dv), jnp.float32)
    _, o_inter = lax.scan(step, s0, xs)
    o = o_intra + jnp.moveaxis(o_inter, 0, 2)
    return o.reshape(bsz, nh, s, dv)


def to_heads(t, d):
    bsz, s, _ = t.shape
    return t.reshape(bsz, s, -1, d).transpose(0, 2, 1, 3)


def hybrid_mixer(h, w_in, w_gk_f, b_gk_f, w_gk_b, b_gk_b, gla_norm_g, conv_w, conv_b, w_out):
    bsz, s, _ = h.shape
    proj = jnp.einsum('bsd,de->bse', h, w_in)
    idx = np.cumsum(SPLITS)[:-1].tolist()
    (q, k, v, z_a, lr_f, lr_b, b_gate, c_gate, h_c, z_c) = jnp.split(proj, idx, axis=-1)
    f32 = jnp.float32
    q = to_heads(q.astype(f32), GLA_DK) * (GLA_DK ** -0.5)
    k = to_heads(k.astype(f32), GLA_DK)
    v = to_heads(v.astype(f32), GLA_DV)
    g_f = jax.nn.log_sigmoid(jnp.einsum('bsr,re->bse', lr_f.astype(f32), w_gk_f.astype(f32))
                             + b_gk_f.astype(f32)) / GATE_NORM
    g_b = jax.nn.log_sigmoid(jnp.einsum('bsr,re->bse', lr_b.astype(f32), w_gk_b.astype(f32))
                             + b_gk_b.astype(f32)) / GATE_NORM
    g_f = to_heads(g_f, GLA_DK)
    g_b = to_heads(g_b, GLA_DK)
    o_fwd = gla_direction(q, k, v, g_f, strict=False)
    flip = lambda t: jnp.flip(t, axis=2)
    o_bwd = flip(gla_direction(flip(q), flip(k), flip(v), flip(g_b), strict=True))
    o = o_fwd + o_bwd
    o = o * lax.rsqrt(jnp.mean(o * o, axis=-1, keepdims=True) + EPS) * gla_norm_g.astype(f32)
    y_a = o.transpose(0, 2, 1, 3).reshape(bsz, s, GLA_V_W)
    y_a = (y_a * jax.nn.silu(z_a.astype(f32))).astype(h.dtype)
    u = c_gate * h_c
    up = jnp.pad(u, ((0, 0), (1, 1), (0, 0)))
    conv = (conv_w[0] * up[:, :-2] + conv_w[1] * up[:, 1:-1] + conv_w[2] * up[:, 2:]) + conv_b
    y_c = b_gate * conv * jax.nn.silu(z_c)
    y = jnp.concatenate([y_a, y_c.astype(h.dtype)], axis=-1)
    return jnp.einsum('bse,ed->bsd', y, w_out)


def setup_inputs(seed: int = 0) -> dict:
    key = jax.random.key(seed)
    ks = jax.random.split(key, 14)
    nrm = lambda k_, shp, sc: jax.random.normal(k_, shp, jnp.float32) * sc
    return {
        "x": nrm(ks[0], (BATCH, SEQ, D_MODEL), 1.0),
        "norm_g": 1.0 + nrm(ks[1], (DEPTH, D_MODEL), 0.02),
        "w_in": nrm(ks[2], (DEPTH, D_MODEL, IN_W), D_MODEL ** -0.5),
        "w_gk_f": nrm(ks[3], (DEPTH, GATE_RANK, GLA_QK_W), GATE_RANK ** -0.5),
        "b_gk_f": nrm(ks[4], (DEPTH, GLA_QK_W), 0.1),
        "w_gk_b": nrm(ks[5], (DEPTH, GATE_RANK, GLA_QK_W), GATE_RANK ** -0.5),
        "b_gk_b": nrm(ks[6], (DEPTH, GLA_QK_W), 0.1),
        "gla_norm_g": 1.0 + nrm(ks[7], (DEPTH, GLA_DV), 0.02),
        "conv_w": nrm(ks[8], (DEPTH, CONV_WIDTH, CONV_W), CONV_WIDTH ** -0.5),
        "conv_b": nrm(ks[9], (DEPTH, CONV_W), 0.02),
        "w_out": nrm(ks[10], (DEPTH, MIX_W, D_MODEL), MIX_W ** -0.5),
        "final_g": 1.0 + nrm(ks[11], (D_MODEL,), 0.02),
    }


def reference(x, norm_g, w_in, w_gk_f, b_gk_f, w_gk_b, b_gk_b, gla_norm_g, conv_w, conv_b, w_out, final_g):
    for layer in range(DEPTH):
        h = rmsnorm(x, norm_g[layer])
        x = x + hybrid_mixer(h, w_in[layer], w_gk_f[layer], b_gk_f[layer], w_gk_b[layer],
                             b_gk_b[layer], gla_norm_g[layer], conv_w[layer], conv_b[layer],
                             w_out[layer])
    return rmsnorm(x, final_g)
```

```cpp
#include <hip/hip_runtime.h>
#include <hip/hip_cooperative_groups.h>
#include <cstdio>
#include <cstdint>
namespace cg = cooperative_groups;
namespace pg8 {
#define PG8_LAS __attribute__((address_space(3)))
typedef unsigned short bf16_t;
typedef short bf16x8 __attribute__((ext_vector_type(8)));
typedef float f32x4 __attribute__((ext_vector_type(4)));
typedef unsigned u32x4 __attribute__((ext_vector_type(4)));
constexpr int BM = 256, BK = 64, HALF = 128, HTB = HALF * BK * 2  , STAGE_BYTES = 8 * HTB, NXCD = 8, WGM = 8;

__host__ __device__ __forceinline__ int lds_byte(int r, int c) { const int st = (r >> 4) * 2 + (c >> 5), rr = r & 15, cc = c & 31, ob = rr * 64 + cc * 2; return st * 1024 + (ob ^ (((ob >> 9) & 1) << 5)); }
__host__ __device__ __forceinline__ void stage_rc(int b, int& R, int& C) { const int st = b / 1024, sb = b % 1024, swz = sb ^ (((sb >> 9) & 1) << 5); R = (st >> 1) * 16 + swz / 64; C = (st & 1) * 32 + (swz % 64) / 2; }
__host__ __device__ __forceinline__ int perm32(int rho) { const int n = rho >> 4, i = rho & 15; return 8 * (i >> 2) + 4 * n + (i & 3); }

struct Unit { int pm, pn; };
struct Gemm { const bf16_t* A; const bf16_t* Bt; int M, N, K; };

struct StaticOrder {
    int nM, nN, nwg, G, c;
    __host__ __device__ void init(int M, int N, int G_, int c_) { nM = M / BM; nN = N / BM; nwg = nM * nN; G = G_; c = c_; }
    __host__ __device__ bool next(int i, Unit& u) const {
        const long L = (long)i * G + c; if (L >= nwg) return false;
        int wgid = (int)L; { const int q = nwg / NXCD, r = nwg % NXCD, xcd = wgid % NXCD, off = wgid / NXCD; wgid = (xcd < r ? xcd * (q + 1) : r * (q + 1) + (xcd - r) * q) + off; }
        const int nig = WGM * nN, gid = wgid / nig, fm = gid * WGM, gsz = (nM - fm) < WGM ? (nM - fm) : WGM;
        u.pm = fm + ((wgid % nig) % gsz); u.pn = (wgid % nig) / gsz; return true;
    }
    __device__ __forceinline__ void a_ready(const Unit&) const {}
    __device__ __forceinline__ void done(const Unit&) const {}
};

typedef float f32x2 __attribute__((ext_vector_type(2)));
template <class Epi, class Sched, bool ALIGN_EPI = false, bool SP2 = false>
__device__ __forceinline__ void gemm_phase(PG8_LAS unsigned char* lds, const Gemm g, const Sched& S, const Epi& E) {
    const int tid = threadIdx.x, wid = __builtin_amdgcn_readfirstlane(tid >> 6), lane = tid & 63, wr = wid >> 2, wc = wid & 3, fr = lane & 15, fq = lane >> 4;
    const int K = g.K, nt = K / BK;
    unsigned voffA[2], voffB[2];
#pragma unroll
    for (int i = 0; i < 2; ++i) { int R, C; stage_rc(tid * 16 + i * 8192, R, C); const int Rb = Epi::PERM ? ((R & ~31) + perm32(R & 31)) : R;
        voffA[i] = (unsigned)(R * K + C) * 2u; voffB[i] = (unsigned)(Rb * K + C) * 2u; }
    const size_t kstep = (size_t)(BK * 2);
    const size_t hstep = (size_t)HALF * K * 2;
    const size_t tstep = 2 * hstep;
    const unsigned ldsw = (unsigned)wid * 1024u;
    const int aoff = lds_byte(wr * 64 + fr, fq * 8), boff = lds_byte(wc * 32 + fr, fq * 8);
#define PG8_SA(b, h) (((b) * 2 + (h)) * HTB)
#define PG8_SB(b, h) ((4 + (b) * 2 + (h)) * HTB)
#define PG8_STAGE(bufoff, gbase, voff) do { _Pragma("unroll") for (int _i = 0; _i < 2; ++_i) \
        __builtin_amdgcn_global_load_lds((const unsigned*)((const char*)(gbase) + (voff)[_i]), (PG8_LAS unsigned*)(lds + (bufoff) + ldsw + _i * 8192), 16, 0, 0); } while (0)
#define PG8_LDA(dst, b, h) do { _Pragma("unroll") for (int m = 0; m < 4; ++m) _Pragma("unroll") for (int k = 0; k < 2; ++k) dst[m][k] = *(const PG8_LAS bf16x8*)(lds + PG8_SA(b, h) + aoff + m * 2048 + k * 1024); } while (0)
#define PG8_LDB(dst, b, h) do { _Pragma("unroll") for (int n = 0; n < 2; ++n) _Pragma("unroll") for (int k = 0; k < 2; ++k) dst[n][k] = *(const PG8_LAS bf16x8*)(lds + PG8_SB(b, h) + boff + n * 2048 + k * 1024); } while (0)
#define PG8_MMA(ai, bj, At, Bt) do { __builtin_amdgcn_s_setprio(1); _Pragma("unroll") for (int m = 0; m < 4; ++m) _Pragma("unroll") for (int n = 0; n < 2; ++n) _Pragma("unroll") for (int k = 0; k < 2; ++k) \
        acc[ai][bj][m][n] = __builtin_amdgcn_mfma_f32_16x16x32_bf16(Bt[n][k], At[m][k], acc[ai][bj][m][n], 0, 0, 0); __builtin_amdgcn_s_setprio(0); } while (0)
#define PG8_WAIT_V(n) asm volatile("s_waitcnt vmcnt(" #n ")" ::: "memory")
#define PG8_WAIT_L(n) asm volatile("s_waitcnt lgkmcnt(" #n ")" ::: "memory")
#define PG8_BAR __builtin_amdgcn_s_barrier()
#define PG8_SCHED __builtin_amdgcn_sched_barrier(0)
    Unit cur, nxt; int ui = 0;
    if (!S.next(0, cur)) return;
    f32x4 acc[2][2][4][2];
#pragma unroll
    for (int a = 0; a < 2; ++a)
#pragma unroll
        for (int b = 0; b < 2; ++b)
#pragma unroll
            for (int m = 0; m < 4; ++m)
#pragma unroll
                for (int n = 0; n < 2; ++n) acc[a][b][m][n] = (f32x4){0.f, 0.f, 0.f, 0.f};
    bf16x8 At[4][2], B0[2][2], B1[2][2];
    const char* cA = (const char*)g.A + (size_t)cur.pm * tstep; const char* cB = (const char*)g.Bt + (size_t)cur.pn * tstep;
    S.a_ready(cur);
    if constexpr (SP2) {
        PG8_STAGE(PG8_SB(0, 0), cB, voffB); PG8_STAGE(PG8_SB(0, 1), cB + hstep, voffB); PG8_STAGE(PG8_SA(0, 0), cA, voffA); PG8_STAGE(PG8_SA(0, 1), cA + hstep, voffA);
        if (wr == 1) PG8_BAR;
        PG8_WAIT_V(2); PG8_BAR;
        PG8_STAGE(PG8_SB(1, 0), cB + kstep, voffB); PG8_STAGE(PG8_SA(1, 0), cA + kstep, voffA); PG8_STAGE(PG8_SB(1, 1), cB + hstep + kstep, voffB);
        PG8_WAIT_V(6); PG8_BAR;
    } else {
        PG8_STAGE(PG8_SB(0, 0), cB, voffB); PG8_STAGE(PG8_SA(0, 0), cA, voffA); PG8_STAGE(PG8_SB(0, 1), cB + hstep, voffB); PG8_STAGE(PG8_SA(0, 1), cA + hstep, voffA);
        if (wr == 1) PG8_BAR;
        PG8_WAIT_V(4); PG8_BAR;
        PG8_STAGE(PG8_SB(1, 0), cB + kstep, voffB); PG8_STAGE(PG8_SA(1, 0), cA + kstep, voffA); PG8_STAGE(PG8_SB(1, 1), cB + hstep + kstep, voffB);
        PG8_WAIT_V(6); PG8_BAR;
    }
    for (;;) {
        const bool has_next = S.next(ui + 1, nxt);
        const char* nA = has_next ? (const char*)g.A + (size_t)nxt.pm * tstep : cA; const char* nB = has_next ? (const char*)g.Bt + (size_t)nxt.pn * tstep : cB;
        for (int t = 0; t < nt; t += 2) {
            const bool last = (t == nt - 2);
            const char* a1 = cA + (size_t)(t + 1) * kstep;
            const char* a2 = last ? nA : cA + (size_t)(t + 2) * kstep; const char* b2 = last ? nB : cB + (size_t)(t + 2) * kstep;
            const char* a3 = a2 + kstep; const char* b3 = b2 + kstep;
            if (last && has_next) S.a_ready(nxt);
            if constexpr (SP2) {
            PG8_LDB(B0, 0, 0); PG8_LDB(B1, 0, 1); PG8_SCHED; PG8_LDA(At, 0, 0); PG8_STAGE(PG8_SA(1, 1), a1 + hstep, voffA);
            PG8_WAIT_V(8); PG8_WAIT_L(0); PG8_BAR; PG8_MMA(0, 0, At, B0); PG8_MMA(0, 1, At, B1); PG8_BAR; PG8_SCHED;
            PG8_LDA(At, 0, 1); PG8_STAGE(PG8_SB(0, 0), b2, voffB); PG8_STAGE(PG8_SB(0, 1), b2 + hstep, voffB); PG8_STAGE(PG8_SA(0, 0), a2, voffA);
            PG8_WAIT_V(8); PG8_WAIT_L(0); PG8_BAR; PG8_MMA(1, 0, At, B0); PG8_MMA(1, 1, At, B1); PG8_BAR; PG8_SCHED;
            PG8_LDB(B0, 1, 0); PG8_LDB(B1, 1, 1); PG8_SCHED; PG8_LDA(At, 1, 0); PG8_STAGE(PG8_SA(0, 1), a2 + hstep, voffA);
            PG8_WAIT_V(8); PG8_WAIT_L(0); PG8_BAR; PG8_MMA(0, 0, At, B0); PG8_MMA(0, 1, At, B1); PG8_BAR; PG8_SCHED;
            PG8_LDA(At, 1, 1); PG8_STAGE(PG8_SB(1, 0), b3, voffB); PG8_STAGE(PG8_SB(1, 1), b3 + hstep, voffB); PG8_STAGE(PG8_SA(1, 0), a3, voffA);
            PG8_WAIT_V(8); PG8_WAIT_L(0); PG8_BAR; PG8_MMA(1, 0, At, B0); PG8_MMA(1, 1, At, B1); PG8_BAR; PG8_SCHED;
            } else {
            PG8_LDB(B0, 0, 0); PG8_SCHED; PG8_LDA(At, 0, 0); PG8_STAGE(PG8_SA(1, 1), a1 + hstep, voffA);
            PG8_WAIT_L(8); PG8_BAR; PG8_WAIT_L(0); PG8_MMA(0, 0, At, B0); PG8_BAR; PG8_SCHED;
            PG8_LDB(B1, 0, 1); PG8_STAGE(PG8_SB(0, 0), b2, voffB);
            PG8_BAR; PG8_WAIT_L(0); PG8_MMA(0, 1, At, B1); PG8_BAR;
            PG8_LDA(At, 0, 1); PG8_STAGE(PG8_SA(0, 0), a2, voffA);
            PG8_BAR; PG8_WAIT_L(0); PG8_MMA(1, 0, At, B0); PG8_BAR; PG8_SCHED;
            PG8_STAGE(PG8_SB(0, 1), b2 + hstep, voffB);
            PG8_WAIT_V(6); PG8_BAR; PG8_MMA(1, 1, At, B1); PG8_BAR;
            PG8_LDB(B0, 1, 0); PG8_SCHED; PG8_LDA(At, 1, 0); PG8_STAGE(PG8_SA(0, 1), a2 + hstep, voffA);
            PG8_WAIT_L(8); PG8_BAR; PG8_WAIT_L(0); PG8_MMA(0, 0, At, B0); PG8_BAR; PG8_SCHED;
            PG8_LDB(B1, 1, 1); PG8_STAGE(PG8_SB(1, 0), b3, voffB);
            PG8_BAR; PG8_WAIT_L(0); PG8_MMA(0, 1, At, B1); PG8_BAR;
            PG8_LDA(At, 1, 1); PG8_STAGE(PG8_SA(1, 0), a3, voffA);
            PG8_BAR; PG8_WAIT_L(0); PG8_MMA(1, 0, At, B0); PG8_BAR; PG8_SCHED;
            PG8_STAGE(PG8_SB(1, 1), b3 + hstep, voffB);
            PG8_WAIT_V(6); PG8_BAR; PG8_MMA(1, 1, At, B1); PG8_BAR;
            }
        }
        if constexpr (ALIGN_EPI) { if (wr == 0) PG8_BAR; }
        if constexpr (!Epi::AFTER_DRAIN) { E(acc, cur, wr, wc, fr, fq); S.done(cur); }
        if (!has_next) break;
#pragma unroll
        for (int a = 0; a < 2; ++a)
#pragma unroll
            for (int b = 0; b < 2; ++b)
#pragma unroll
                for (int m = 0; m < 4; ++m)
#pragma unroll
                    for (int n = 0; n < 2; ++n) acc[a][b][m][n] = (f32x4){0.f, 0.f, 0.f, 0.f};
        cur = nxt; cA = nA; cB = nB; ++ui;
        if constexpr (ALIGN_EPI) { if (wr == 1) PG8_BAR; }
    }
    PG8_WAIT_V(0);
    if constexpr (!ALIGN_EPI) { if (wr == 0) PG8_BAR; }
    PG8_BAR;
    if constexpr (Epi::AFTER_DRAIN) { E.fused(acc, cur, wr, wc, fr, fq, lds, wid, lane); S.done(cur); }
#undef PG8_SA
#undef PG8_SB
#undef PG8_STAGE
#undef PG8_LDA
#undef PG8_LDB
#undef PG8_MMA
#undef PG8_WAIT_V
#undef PG8_WAIT_L
#undef PG8_BAR
#undef PG8_SCHED
}
}

#ifndef MK_MULTI
#define MK_MULTI 0
#endif
#define LAS __attribute__((address_space(3)))
typedef unsigned short bf16_t;
typedef short bf16x8 __attribute__((ext_vector_type(8)));
typedef float f32x4 __attribute__((ext_vector_type(4)));
typedef float f32x2v __attribute__((ext_vector_type(2)));
typedef unsigned u32x4 __attribute__((ext_vector_type(4)));
typedef unsigned u32x2 __attribute__((ext_vector_type(2)));
#define MFMA16(a, b, c) __builtin_amdgcn_mfma_f32_16x16x32_bf16((a), (b), (c), 0, 0, 0)

constexpr int NB = 8, SEQ = 4096, DM = 1024, M = NB * SEQ;
constexpr int INW = 7200, NPAD = 7424, MIXW = 2048;
constexpr int CH = 64;
constexpr float EPS = 1e-6f;
constexpr int NPH = 6;
constexpr int LDS_BYTES = 158784;
constexpr int L_BARW = 158720;
constexpr size_t WS_BAR = 384 * 1024;
constexpr size_t MiB = (size_t)1 << 20;
constexpr size_t WS_SSQ = 0, WS_WOT = 1 * MiB, WS_LR = 5 * MiB, WS_EV = 9 * MiB, WS_WINT = 13 * MiB;
constexpr size_t WS_V = 32 * MiB, WS_ZA = 96 * MiB, WS_Y = 160 * MiB;
constexpr size_t WS_Q = 288 * MiB, WS_K = 320 * MiB, WS_U = 352 * MiB, WS_BZ = 416 * MiB;
constexpr size_t WS_OF = 288 * MiB, WS_OB = 352 * MiB, WS_END = 481 * MiB;

struct Ctx {
    const float *x, *norm_g, *w_in, *wgf, *bgf, *wgb, *bgb, *gng, *conv_w, *conv_b, *w_out, *final_g;
    float* out; float* ssq; unsigned* cnt; float* LR; float* EV;
    bf16_t *WOT, *WINT, *V, *ZA, *Y, *Q, *K, *U, *BZ, *OF, *OB, *XB, *QAF, *KAF, *QAB, *KAB;
};

typedef __bf16 bf16x2_t __attribute__((ext_vector_type(2)));
__device__ __forceinline__ unsigned pkbf(float lo, float hi) { const f32x2v v = {lo, hi}; const bf16x2_t b = __builtin_convertvector(v, bf16x2_t); return __builtin_bit_cast(unsigned, b); }
__device__ __forceinline__ float bflo(unsigned u) { return __uint_as_float(u << 16); }
__device__ __forceinline__ float bfhi(unsigned u) { return __uint_as_float(u & 0xffff0000u); }
__device__ __forceinline__ float silu_f(float z) { return z * __builtin_amdgcn_rcpf(1.0f + __builtin_amdgcn_exp2f(z * -1.4426950408889634f)); }
__device__ __forceinline__ float wave_sum(float v) {
#pragma unroll
    for (int o = 1; o < 64; o <<= 1) v += __shfl_xor(v, o);
    return v;
}

__device__ __forceinline__ int in_srccol(int nb) {
    const int pn = nb >> 3, wb = nb & 7;
    if (pn < 12) return nb * 32;
    if (pn < 20) { const int j = pn - 12; return wb < 4 ? 4128 + 128 * j + 32 * wb : 5152 + 128 * j + 32 * (wb - 4); }
    if (pn < 28) { const int j = pn - 20; return wb < 4 ? 3104 + 128 * j + 32 * wb : 6176 + 128 * j + 32 * (wb - 4); }
    return wb == 0 ? 3072 : -1;
}
__device__ __forceinline__ void p0_transpose_item(const float* W, int N, int K, bf16_t* WT, int k0, int srccol, int dstrow0, const float* gs, LAS float* scr, int lane) {
    float vv[32], gg[32];
    const int sc_ = srccol >= 0 ? srccol : 0;
#pragma unroll
    for (int i = 0; i < 32; ++i) { const int kk = 2 * i + (lane >> 5); vv[i] = W[(size_t)(k0 + kk) * N + sc_ + (lane & 31)]; gg[i] = gs ? gs[k0 + kk] : 1.0f; }
#pragma unroll
    for (int i = 0; i < 32; ++i) { const int kk = 2 * i + (lane >> 5); scr[kk * 33 + (lane & 31)] = srccol >= 0 ? vv[i] * gg[i] : 0.f; }
    asm volatile("s_waitcnt lgkmcnt(0)" ::: "memory");
    const int c = lane & 7;
#pragma unroll
    for (int j = 0; j < 4; ++j) { const int n = (lane >> 3) + 8 * j; const LAS float* s = scr + (8 * c) * 33 + n;
        u32x4 o; o.x = pkbf(s[0 * 33], s[1 * 33]); o.y = pkbf(s[2 * 33], s[3 * 33]); o.z = pkbf(s[4 * 33], s[5 * 33]); o.w = pkbf(s[6 * 33], s[7 * 33]);
        *(u32x4*)(WT + (size_t)(dstrow0 + n) * K + k0 + 8 * c) = o; }
    asm volatile("s_waitcnt lgkmcnt(0)" ::: "memory");
}
__device__ __forceinline__ void phase0(const Ctx& c, LAS unsigned char* lds) {
    const int tid = threadIdx.x, lane = tid & 63, w = tid >> 6;
    const int gw = blockIdx.x * 8 + w, NGW = gridDim.x * 8;
    LAS float* scr = (LAS float*)(lds + w * 16384);
    constexpr int I_IN = 16 * 232, I_OUT = 32 * 32;
    for (int it = gw; it < I_IN + I_OUT; it += NGW) {
        if (it < I_IN) { const int kb = it / 232, nb = it % 232; p0_transpose_item(c.w_in, INW, DM, c.WINT, 64 * kb, in_srccol(nb), 32 * nb, c.norm_g, scr, lane); }
        else { const int r = it - I_IN, kb = r / 32, nb = r % 32; p0_transpose_item(c.w_out, DM, MIXW, c.WOT, 64 * kb, 32 * nb, 32 * nb, nullptr, scr, lane); }
    }
    for (int i = blockIdx.x * 512 + tid; i < M; i += gridDim.x * 512) c.ssq[i] = 0.f;
    for (int i = blockIdx.x * 512 + tid; i < 256 * 64; i += gridDim.x * 512) c.cnt[i] = 0u;
    for (int m0 = gw * 8; m0 < M; m0 += NGW * 8) {
        f32x4 v[8][4];
#pragma unroll
        for (int rr = 0; rr < 8; ++rr) { const f32x4* xr = (const f32x4*)(c.x + (size_t)(m0 + rr) * DM) + lane;
#pragma unroll
            for (int j = 0; j < 4; ++j) v[rr][j] = __builtin_nontemporal_load(xr + 64 * j); }
#pragma unroll
        for (int rr = 0; rr < 8; ++rr) { float s = 0.f;
#pragma unroll
            for (int j = 0; j < 4; ++j) s += (v[rr][j].x * v[rr][j].x + v[rr][j].y * v[rr][j].y) + (v[rr][j].z * v[rr][j].z + v[rr][j].w * v[rr][j].w);
            const float rstd = 1.0f / sqrtf(wave_sum(s) * (1.0f / DM) + EPS);
            u32x2* o8 = (u32x2*)(c.XB + (size_t)(m0 + rr) * DM) + lane;
#pragma unroll
            for (int j = 0; j < 4; ++j) { u32x2 o; o.x = pkbf(v[rr][j].x * rstd, v[rr][j].y * rstd); o.y = pkbf(v[rr][j].z * rstd, v[rr][j].w * rstd); o8[64 * j] = o; } }
    }
}

struct EpiIn {
    static constexpr bool PERM = true, AFTER_DRAIN = false;
    unsigned char* ws;
    __device__ __forceinline__ void operator()(const f32x4 (&acc)[2][2][4][2], const pg8::Unit& u, int wr, int wc, int fr, int fq) const {
        bf16_t* const Q = (bf16_t*)(ws + WS_Q); bf16_t* const K = (bf16_t*)(ws + WS_K); bf16_t* const V = (bf16_t*)(ws + WS_V); bf16_t* const ZA = (bf16_t*)(ws + WS_ZA);
        bf16_t* const U = (bf16_t*)(ws + WS_U); bf16_t* const BZ = (bf16_t*)(ws + WS_BZ); float* const LR = (float*)(ws + WS_LR);
        const int pn = u.pn; const int row0 = u.pm * 256 + wr * 64 + fr; const int cl = wc * 32 + 8 * fq;
        if (pn >= 4 && pn < 8) {
            const int hh = pn - 4, cs = (wc & 1) * 32 + 8 * fq;
#pragma unroll
            for (int ai = 0; ai < 2; ++ai)
#pragma unroll
                for (int m = 0; m < 4; ++m) { const int row = row0 + ai * 128 + m * 16; const int bb = row >> 12, ss = row & 4095;
#pragma unroll
                    for (int bj = 0; bj < 2; ++bj) { const int dvs = 2 * bj + (wc >> 1); const f32x4 v0 = acc[ai][bj][m][0], v1 = acc[ai][bj][m][1];
                        u32x4 o; o.x = pkbf(v0[0], v0[1]); o.y = pkbf(v0[2], v0[3]); o.z = pkbf(v1[0], v1[1]); o.w = pkbf(v1[2], v1[3]);
                        __builtin_nontemporal_store(o, (u32x4*)(V + ((size_t)(((bb * 4 + hh) * 4 + dvs) * 4096 + ss)) * 64 + cs)); } }
        } else if (pn < 4) {
            bf16_t* base; int pitch, col; float sc = 1.0f;
            if (pn < 2) { base = Q; pitch = 512; col = pn * 256; sc = 0.08838834764831845f; }
            else { base = K; pitch = 512; col = (pn - 2) * 256; }
#pragma unroll
            for (int ai = 0; ai < 2; ++ai)
#pragma unroll
                for (int m = 0; m < 4; ++m) { bf16_t* rowp = base + (size_t)(row0 + ai * 128 + m * 16) * pitch + col + cl;
#pragma unroll
                    for (int bj = 0; bj < 2; ++bj) { const f32x4 v0 = acc[ai][bj][m][0] * sc, v1 = acc[ai][bj][m][1] * sc;
                        u32x4 o; o.x = pkbf(v0[0], v0[1]); o.y = pkbf(v0[2], v0[3]); o.z = pkbf(v1[0], v1[1]); o.w = pkbf(v1[2], v1[3]);
                        __builtin_nontemporal_store(o, (u32x4*)(rowp + bj * 128)); } }
        } else if (pn < 12) {
            const int col = (pn - 8) * 256;
#pragma unroll
            for (int ai = 0; ai < 2; ++ai)
#pragma unroll
                for (int m = 0; m < 4; ++m) { bf16_t* rowp = ZA + (size_t)(row0 + ai * 128 + m * 16) * 1024 + col + cl;
#pragma unroll
                    for (int bj = 0; bj < 2; ++bj) { const f32x4 v0 = acc[ai][bj][m][0], v1 = acc[ai][bj][m][1];
                        u32x4 o; o.x = pkbf(v0[0], v0[1]); o.y = pkbf(v0[2], v0[3]); o.z = pkbf(v1[0], v1[1]); o.w = pkbf(v1[2], v1[3]);
                        __builtin_nontemporal_store(o, (u32x4*)(rowp + bj * 128)); } }
        } else if (pn < 20) {
            const int col = (pn - 12) * 128;
#pragma unroll
            for (int ai = 0; ai < 2; ++ai)
#pragma unroll
                for (int m = 0; m < 4; ++m) { bf16_t* rowp = U + (size_t)(row0 + ai * 128 + m * 16) * 1024 + col + cl;
                    const f32x4 v0 = acc[ai][0][m][0] * acc[ai][1][m][0], v1 = acc[ai][0][m][1] * acc[ai][1][m][1];
                    u32x4 o; o.x = pkbf(v0[0], v0[1]); o.y = pkbf(v0[2], v0[3]); o.z = pkbf(v1[0], v1[1]); o.w = pkbf(v1[2], v1[3]);
                    __builtin_nontemporal_store(o, (u32x4*)rowp); }
        } else if (pn < 28) {
            const int col = (pn - 20) * 128;
#pragma unroll
            for (int ai = 0; ai < 2; ++ai)
#pragma unroll
                for (int m = 0; m < 4; ++m) { bf16_t* rowp = BZ + (size_t)(row0 + ai * 128 + m * 16) * 1024 + col + cl;
                    const f32x4 b0 = acc[ai][0][m][0], b1 = acc[ai][0][m][1], z0 = acc[ai][1][m][0], z1 = acc[ai][1][m][1];
                    u32x4 o; o.x = pkbf(b0[0] * silu_f(z0[0]), b0[1] * silu_f(z0[1])); o.y = pkbf(b0[2] * silu_f(z0[2]), b0[3] * silu_f(z0[3]));
                    o.z = pkbf(b1[0] * silu_f(z1[0]), b1[1] * silu_f(z1[1])); o.w = pkbf(b1[2] * silu_f(z1[2]), b1[3] * silu_f(z1[3]));
                    __builtin_nontemporal_store(o, (u32x4*)rowp); }
        } else {
            if (wc == 0) {
#pragma unroll
                for (int ai = 0; ai < 2; ++ai)
#pragma unroll
                    for (int m = 0; m < 4; ++m) { float* rowp = LR + (size_t)(row0 + ai * 128 + m * 16) * 32 + 8 * fq;
                        *(f32x4*)rowp = acc[ai][0][m][0]; *(f32x4*)(rowp + 4) = acc[ai][0][m][1]; }
            }
        }
    }
};

__device__ __forceinline__ float logsig16(float z) { const float zl = z * 1.4426950408889634f; return (fminf(zl, 0.f) - __builtin_amdgcn_logf(1.0f + __builtin_amdgcn_exp2f(-fabsf(zl)))) * 0.0625f; }
__device__ __forceinline__ void gla_pre_item(const Ctx& c, int item, int next_item, f32x4& lrv, const float (&wg0)[2][16], const float (&wg1)[2][16], const float (&bgv)[2][2], LAS unsigned char* lds) {
    const int h = item & 3, n = (item >> 2) & 63, b = item >> 8;
    const int tid = threadIdx.x, lane = tid & 63, w = __builtin_amdgcn_readfirstlane(tid >> 6);
    const size_t tb = (size_t)b * SEQ + (size_t)n * CH;
    LAS float* lrs = (LAS float*)lds;
    LAS float* tots = (LAS float*)(lds + 8192);
    LAS float* gref = (LAS float*)(lds + 16384);
    const int d = 2 * lane, col = h * 128 + d;
    *(LAS f32x4*)(lrs + tid * 4) = lrv;
    const int odd = lane & 1, colp = h * 128 + 2 * (lane & ~1);
    u32x2 qv[4], kv[4];
#pragma unroll
    for (int ip = 0; ip < 4; ++ip) { const size_t off = (tb + 8 * w + 2 * ip + odd) * 512 + colp; qv[ip] = *(const u32x2*)(c.Q + off); kv[ip] = *(const u32x2*)(c.K + off); }
    { const int ni = next_item >= 0 ? next_item : item; const int n2 = (ni >> 2) & 63, b2 = ni >> 8; lrv = *(const f32x4*)(c.LR + ((size_t)b2 * SEQ + (size_t)n2 * CH) * 32 + tid * 4); }
    __syncthreads();
    float g[2][8][2];
#pragma unroll
    for (int dir = 0; dir < 2; ++dir) {
#pragma unroll
        for (int i = 0; i < 8; ++i) { const LAS float* lr = lrs + (8 * w + i) * 32 + dir * 16; f32x2v z = {bgv[dir][0], bgv[dir][1]};
#pragma unroll
            for (int r4 = 0; r4 < 4; ++r4) { const f32x4 l = *(const LAS f32x4*)(lr + 4 * r4);
#pragma unroll
                for (int e = 0; e < 4; ++e) { const f32x2v wv = {wg0[dir][4 * r4 + e], wg1[dir][4 * r4 + e]}; const f32x2v lv = {l[e], l[e]}; z = __builtin_elementwise_fma(lv, wv, z); } }
            g[dir][i][0] = logsig16(z.x); g[dir][i][1] = logsig16(z.y); }
    }
#pragma unroll
    for (int dd = 0; dd < 2; ++dd) {
        float s = 0.f;
#pragma unroll
        for (int i = 0; i < 8; ++i) { s += g[0][i][dd]; g[0][i][dd] = s; }
        tots[(0 * 8 + w) * 128 + d + dd] = s;
        s = 0.f;
#pragma unroll
        for (int i = 7; i >= 0; --i) { s += g[1][i][dd]; g[1][i][dd] = s; }
        tots[(1 * 8 + w) * 128 + d + dd] = s;
    }
    if (w == 4) { gref[d] = g[0][0][0]; gref[d + 1] = g[0][0][1]; }
    if (w == 3) { gref[128 + d] = g[1][7][0]; gref[128 + d + 1] = g[1][7][1]; }
    __syncthreads();
    float pre[2][2], bref[2][2], ball[2][2];
#pragma unroll
    for (int dd = 0; dd < 2; ++dd) {
        float pf = 0.f, af = 0.f, rf = 0.f, pb = 0.f, ab = 0.f, rb = 0.f;
#pragma unroll
        for (int ww = 0; ww < 8; ++ww) { const float tf = tots[ww * 128 + d + dd], tbk = tots[(8 + ww) * 128 + d + dd];
            af += tf; ab += tbk; if (ww < w) pf += tf; if (ww > w) pb += tbk; if (ww < 4) rf += tf; if (ww > 3) rb += tbk; }
        pre[0][dd] = pf; pre[1][dd] = pb; ball[0][dd] = af; ball[1][dd] = ab;
        bref[0][dd] = rf + gref[d + dd]; bref[1][dd] = rb + gref[128 + d + dd];
    }
    if (w == 0) {
#pragma unroll
        for (int dir = 0; dir < 2; ++dir) { float* ev = c.EV + (size_t)((((b * 4 + h) * 2 + dir) * 64) + n) * 256;
            f32x2v e1; e1.x = __builtin_amdgcn_exp2f(bref[dir][0]); e1.y = __builtin_amdgcn_exp2f(bref[dir][1]);
            f32x2v e2; e2.x = __builtin_amdgcn_exp2f(ball[dir][0] - bref[dir][0]); e2.y = __builtin_amdgcn_exp2f(ball[dir][1] - bref[dir][1]);
            *(f32x2v*)(ev + d) = e1; *(f32x2v*)(ev + 128 + d) = e2; }
    }
    const size_t hbp = ((size_t)(b * 4 + h) * SEQ + (size_t)n * CH) * 128 + 2 * (lane & ~1);
#pragma unroll
    for (int ip = 0; ip < 4; ++ip) {
        const unsigned qr = __shfl_xor(odd ? qv[ip].x : qv[ip].y, 1), kr = __shfl_xor(odd ? kv[ip].x : kv[ip].y, 1);
        const unsigned qa = odd ? qr : qv[ip].x, qb = odd ? qv[ip].y : qr, ka = odd ? kr : kv[ip].x, kb = odd ? kv[ip].y : kr;
        const size_t off = hbp + (size_t)(8 * w + 2 * ip + odd) * 128;
#pragma unroll
        for (int dir = 0; dir < 2; ++dir) {
            const float ea0 = __builtin_amdgcn_exp2f(pre[dir][0] + g[dir][2 * ip][0] - bref[dir][0]), ea1 = __builtin_amdgcn_exp2f(pre[dir][1] + g[dir][2 * ip][1] - bref[dir][1]);
            const float eb0 = __builtin_amdgcn_exp2f(pre[dir][0] + g[dir][2 * ip + 1][0] - bref[dir][0]), eb1 = __builtin_amdgcn_exp2f(pre[dir][1] + g[dir][2 * ip + 1][1] - bref[dir][1]);
            const unsigned qoa = pkbf(bflo(qa) * ea0, bfhi(qa) * ea1), qob = pkbf(bflo(qb) * eb0, bfhi(qb) * eb1);
            const unsigned koa = pkbf(bflo(ka) * __builtin_amdgcn_rcpf(ea0), bfhi(ka) * __builtin_amdgcn_rcpf(ea1)), kob = pkbf(bflo(kb) * __builtin_amdgcn_rcpf(eb0), bfhi(kb) * __builtin_amdgcn_rcpf(eb1));
            const unsigned qx = __shfl_xor(odd ? qoa : qob, 1), kx = __shfl_xor(odd ? koa : kob, 1);
            u32x2 qo, ko; qo.x = odd ? qx : qoa; qo.y = odd ? qob : qx; ko.x = odd ? kx : koa; ko.y = odd ? kob : kx;
            *(u32x2*)((dir ? c.QAB : c.QAF) + off) = qo;
            *(u32x2*)((dir ? c.KAB : c.KAF) + off) = ko; }
    }
}
__device__ __forceinline__ void unpack8(const u32x4 u, float (&f)[8]) { f[0] = bflo(u.x); f[1] = bfhi(u.x); f[2] = bflo(u.y); f[3] = bfhi(u.y); f[4] = bflo(u.z); f[5] = bfhi(u.z); f[6] = bflo(u.w); f[7] = bfhi(u.w); }
__device__ __forceinline__ void conv_item(const Ctx& c, int cb) {
    const int tid = threadIdx.x, ch = (tid & 127) * 8, tq = tid >> 7;
    float w0[8], w1[8], w2[8], bb[8];
#pragma unroll
    for (int e = 0; e < 8; ++e) { w0[e] = c.conv_w[ch + e]; w1[e] = c.conv_w[1024 + ch + e]; w2[e] = c.conv_w[2048 + ch + e]; bb[e] = c.conv_b[ch + e]; }
    const size_t t0 = (size_t)cb * 64 + 16 * tq; const int pos0 = (int)(t0 % SEQ);
    const u32x4 zero4 = {0u, 0u, 0u, 0u};
    float prev[8], cur[8];
    { u32x4 up = *(const u32x4*)(c.U + (pos0 > 0 ? t0 - 1 : t0) * 1024 + ch); if (pos0 == 0) up = zero4; unpack8(up, prev); }
    unpack8(*(const u32x4*)(c.U + t0 * 1024 + ch), cur);
#pragma unroll
    for (int hb = 0; hb < 2; ++hb) {
        u32x4 un[8], bzr[8];
#pragma unroll
        for (int i = 0; i < 8; ++i) { const size_t t = t0 + 8 * hb + i;
            { const bool inb = (pos0 + 8 * hb + i + 1 < SEQ); un[i] = *(const u32x4*)(c.U + (inb ? t + 1 : t) * 1024 + ch); if (!inb) un[i] = zero4; }
            bzr[i] = *(const u32x4*)(c.BZ + t * 1024 + ch); }
#pragma unroll
        for (int i = 0; i < 8; ++i) { const size_t t = t0 + 8 * hb + i; float nxt[8], bz[8], y[8];
            unpack8(un[i], nxt); unpack8(bzr[i], bz);
#pragma unroll
            for (int e = 0; e < 8; ++e) { y[e] = bz[e] * (w0[e] * prev[e] + w1[e] * cur[e] + w2[e] * nxt[e] + bb[e]); prev[e] = cur[e]; cur[e] = nxt[e]; }
            u32x4 o; o.x = pkbf(y[0], y[1]); o.y = pkbf(y[2], y[3]); o.z = pkbf(y[4], y[5]); o.w = pkbf(y[6], y[7]);
            *(u32x4*)(c.Y + t * 2048 + 1024 + ch) = o; }
    }
}
__device__ __forceinline__ void phase2(const Ctx& c, LAS unsigned char* lds) {
    {
        const int G4 = (int)gridDim.x >> 2, h = (int)blockIdx.x & 3; int p = (int)blockIdx.x >> 2;
        if ((int)blockIdx.x < 4 * G4) {
            const int col = h * 128 + 2 * (threadIdx.x & 63);
            float wg0[2][16], wg1[2][16], bgv[2][2];
#pragma unroll
            for (int dir = 0; dir < 2; ++dir) { const float* Wg = dir ? c.wgb : c.wgf; const float* bg = dir ? c.bgb : c.bgf;
#pragma unroll
                for (int r = 0; r < 16; ++r) { const f32x2v t = *(const f32x2v*)(Wg + r * 512 + col); wg0[dir][r] = t.x; wg1[dir][r] = t.y; }
                const f32x2v bb = *(const f32x2v*)(bg + col); bgv[dir][0] = bb.x; bgv[dir][1] = bb.y; }
            f32x4 lrv = (f32x4){0.f, 0.f, 0.f, 0.f};
            if (p < 512) { const int n0 = p & 63, b0 = p >> 6; lrv = *(const f32x4*)(c.LR + ((size_t)b0 * SEQ + (size_t)n0 * CH) * 32 + threadIdx.x * 4); }
            for (; p < 512; p += G4) { const int pn = p + G4; gla_pre_item(c, p * 4 + h, pn < 512 ? pn * 4 + h : -1, lrv, wg0, wg1, bgv, lds); }
        }
    }
}

constexpr int L_SET = 44032, L_QA = 0, L_KA = 17408, L_V = 34816, L_ATT = 88064  , L_XT = 106496, L_EV = 123904  , L_CV = 125952;
typedef short s16x4 __attribute__((ext_vector_type(4)));
typedef short v4i16_t __attribute__((ext_vector_type(4)));
__device__ __forceinline__ bf16x8 lds16(LAS unsigned char* p) { return *(const LAS bf16x8*)p; }
__device__ __forceinline__ bf16x8 lds_tr(LAS unsigned char* p0, int pitch4) {
    const s16x4 lo = __builtin_bit_cast(s16x4, __builtin_amdgcn_ds_read_tr16_b64_v4i16((LAS v4i16_t*)p0));
    const s16x4 hi = __builtin_bit_cast(s16x4, __builtin_amdgcn_ds_read_tr16_b64_v4i16((LAS v4i16_t*)(p0 + pitch4)));
    return __builtin_shufflevector(lo, hi, 0, 1, 2, 3, 4, 5, 6, 7);
}
#define LDS_BAR() do { asm volatile("s_waitcnt lgkmcnt(0)" ::: "memory"); __builtin_amdgcn_s_barrier(); asm volatile("" ::: "memory"); } while (0)
struct ScanStage { u32x4 q[2], k[2], v, ev, cu0, cu1, cu2, cbz; };
__device__ __forceinline__ void scan_item(const Ctx& c, int item, LAS unsigned char* lds) {
    const int dvs = item & 3, dir = (item >> 2) & 1, h = (item >> 3) & 3, b = item >> 5;
    const int tid = threadIdx.x, lane = tid & 63, w = __builtin_amdgcn_readfirstlane(tid >> 6), r = lane & 15, q = lane >> 4;
    const bf16_t* QA = (dir ? c.QAB : c.QAF) + (size_t)(b * 4 + h) * SEQ * 128;
    const bf16_t* KA = (dir ? c.KAB : c.KAF) + (size_t)(b * 4 + h) * SEQ * 128;
    const bf16_t* Vh = c.V + (size_t)((b * 4 + h) * 4 + dvs) * SEQ * 64;
    bf16_t* O = dir ? c.Y + (size_t)b * SEQ * 2048 + h * 256 + dvs * 64 : c.OF + (size_t)((b * 4 + h) * 4 + dvs) * SEQ * 64;
    const int opitch = dir ? 2048 : 64;
    const float* EV = c.EV + (size_t)(((b * 4 + h) * 2 + dir) * 64) * 256;
    f32x4 T[4];
#pragma unroll
    for (int i = 0; i < 4; ++i) T[i] = (f32x4){0.f, 0.f, 0.f, 0.f};
    ScanStage R0, R1;
    const int cch = (tid & 127) * 8; const size_t ctok0 = (size_t)item * 128 + (tid >> 7);
    f32x4 cw0[2], cw1[2], cw2[2], cwb[2];
#pragma unroll
    for (int e = 0; e < 2; ++e) { cw0[e] = *(const f32x4*)(c.conv_w + cch + 4 * e); cw1[e] = *(const f32x4*)(c.conv_w + 1024 + cch + 4 * e); cw2[e] = *(const f32x4*)(c.conv_w + 2048 + cch + 4 * e); cwb[e] = *(const f32x4*)(c.conv_b + cch + 4 * e); }
    u32x2* const dummy = (u32x2*)((unsigned char*)c.ssq + 480 * MiB) + (size_t)blockIdx.x * 512 + tid;
#define SCAN_LOAD(R, ss, CV) do { const int nn_ = dir ? 63 - (ss) : (ss); \
        (R).q[0] = *(const u32x4*)(QA + (size_t)nn_ * 8192 + tid * 8); (R).q[1] = *(const u32x4*)(QA + (size_t)nn_ * 8192 + 4096 + tid * 8); \
        (R).k[0] = *(const u32x4*)(KA + (size_t)nn_ * 8192 + tid * 8); (R).k[1] = *(const u32x4*)(KA + (size_t)nn_ * 8192 + 4096 + tid * 8); \
        (R).v = *(const u32x4*)(Vh + (size_t)nn_ * 4096 + tid * 8); \
        (R).ev = *(const u32x4*)(EV + (size_t)nn_ * 256 + (tid & 63) * 4); \
        if (CV) { const size_t t_ = ctok0 + 4 * (((ss) - 1) >> 1); const int p_ = (int)(t_ & (SEQ - 1)); \
          (R).cu0 = *(const u32x4*)(c.U + (p_ > 0 ? t_ - 1 : t_) * 1024 + cch); (R).cu1 = *(const u32x4*)(c.U + t_ * 1024 + cch); \
          (R).cu2 = *(const u32x4*)(c.U + (p_ + 1 < SEQ ? t_ + 1 : t_) * 1024 + cch); (R).cbz = *(const u32x4*)(c.BZ + t_ * 1024 + cch); } } while (0)
#define SCAN_PUT(R, set, CV) do { LAS unsigned char* sb_ = lds + (set) * L_SET; \
        *(LAS u32x4*)(sb_ + L_QA + (tid >> 4) * 272 + (tid & 15) * 16) = (R).q[0]; *(LAS u32x4*)(sb_ + L_QA + (32 + (tid >> 4)) * 272 + (tid & 15) * 16) = (R).q[1]; \
        *(LAS u32x4*)(sb_ + L_KA + (tid >> 4) * 272 + (tid & 15) * 16) = (R).k[0]; *(LAS u32x4*)(sb_ + L_KA + (32 + (tid >> 4)) * 272 + (tid & 15) * 16) = (R).k[1]; \
        *(LAS u32x4*)(sb_ + L_V + (tid >> 3) * 144 + (tid & 7) * 16) = (R).v; \
        *(LAS u32x4*)(lds + L_EV + (set) * 1024 + (tid & 63) * 16) = (R).ev;     \
        if (CV) { *(LAS u32x4*)(lds + L_CV + tid * 16) = (R).cu0; *(LAS u32x4*)(lds + L_CV + 8192 + tid * 16) = (R).cu1; *(LAS u32x4*)(lds + L_CV + 16384 + tid * 16) = (R).cu2; *(LAS u32x4*)(lds + L_CV + 24576 + tid * 16) = (R).cbz; } } while (0)
    const int jt = w & 3, tt0 = 2 * (w >> 2), vt = w & 3;
    const int rowoff272 = r * 272 + q * 16, rowoff144 = r * 144 + q * 16;
    const int troff272 = (8 * q + ((lane >> 2) & 3)) * 272 + (lane & 3) * 8, troff144 = (8 * q + ((lane >> 2) & 3)) * 144 + (lane & 3) * 8;
    f32x4 e2prev = (f32x4){1.f, 1.f, 1.f, 1.f};
#define SCAN_ATT(setx, abuf) do { LAS unsigned char* sx_ = lds + (setx) * L_SET; LAS unsigned char* ab_ = lds + L_ATT + (abuf) * 9216; \
        f32x4 c0 = (f32x4){0.f, 0.f, 0.f, 0.f}, c1 = c0; \
        _Pragma("unroll") for (int ks = 0; ks < 4; ++ks) { \
            const bf16x8 a = lds16(sx_ + L_KA + (16 * jt) * 272 + rowoff272 + ks * 64); \
            const bf16x8 b0 = lds16(sx_ + L_QA + (16 * tt0) * 272 + rowoff272 + ks * 64); \
            const bf16x8 b1 = lds16(sx_ + L_QA + (16 * (tt0 + 1)) * 272 + rowoff272 + ks * 64); \
            c0 = MFMA16(a, b0, c0); c1 = MFMA16(a, b1, c1); } \
        const int j0 = 16 * jt + 4 * q; \
        _Pragma("unroll") for (int half = 0; half < 2; ++half) { const int t = 16 * (tt0 + half) + r; const f32x4 cc = half ? c1 : c0; float v[4]; \
            _Pragma("unroll") for (int i = 0; i < 4; ++i) { const int j = j0 + i; const bool keep = dir ? (j > t) : (j <= t); v[i] = keep ? cc[i] : 0.f; } \
            u32x2 o; o.x = pkbf(v[0], v[1]); o.y = pkbf(v[2], v[3]); \
            *(LAS u32x2*)(ab_ + t * 144 + j0 * 2) = o; } } while (0)
#define SCAN_CONV(pi) do { const size_t ct_ = ctok0 + 4 * (pi); const int cpos_ = (int)(ct_ & (SEQ - 1)); \
        u32x4 cup_ = *(const LAS u32x4*)(lds + L_CV + tid * 16); const u32x4 cuc_ = *(const LAS u32x4*)(lds + L_CV + 8192 + tid * 16); \
        u32x4 cun_ = *(const LAS u32x4*)(lds + L_CV + 16384 + tid * 16); const u32x4 cbz_ = *(const LAS u32x4*)(lds + L_CV + 24576 + tid * 16); \
        if (cpos_ == 0) cup_ = (u32x4){0u, 0u, 0u, 0u}; if (cpos_ + 1 >= SEQ) cun_ = (u32x4){0u, 0u, 0u, 0u}; \
        float up_[8], uc_[8], un_[8], bz_[8]; unpack8(cup_, up_); unpack8(cuc_, uc_); unpack8(cun_, un_); unpack8(cbz_, bz_); \
        float y_[8]; \
        _Pragma("unroll") for (int e = 0; e < 8; ++e) y_[e] = bz_[e] * (cw0[e >> 2][e & 3] * up_[e] + cw1[e >> 2][e & 3] * uc_[e] + cw2[e >> 2][e & 3] * un_[e] + cwb[e >> 2][e & 3]); \
        u32x4 yo; yo.x = pkbf(y_[0], y_[1]); yo.y = pkbf(y_[2], y_[3]); yo.z = pkbf(y_[4], y_[5]); yo.w = pkbf(y_[6], y_[7]); \
        *(u32x4*)(c.Y + ct_ * 2048 + 1024 + cch) = yo; } while (0)
    SCAN_LOAD(R0, 0, 0); SCAN_PUT(R0, 0, 0);
    SCAN_LOAD(R0, 1, 1); SCAN_LOAD(R1, 2, 0);
    LDS_BAR();
    SCAN_ATT(0, 0);
#pragma unroll
    for (int k = 0; k < 6; ++k) { asm volatile("" ::: "memory"); *dummy = (u32x2){0u, 0u}; }
    asm volatile("s_waitcnt lgkmcnt(0)" ::: "memory");
#define SCAN_STEP(s, R, CV) do { \
        LAS unsigned char* sb = lds + ((s) & 1) * L_SET; const int n = dir ? 63 - (s) : (s); \
        SCAN_PUT(R, ((s) + 1) & 1, CV); \
        SCAN_LOAD(R, ((s) + 3 < 64 ? (s) + 3 : 63), CV);   \
        { const f32x4 e1v_ = *(const LAS f32x4*)(lds + L_EV + ((s) & 1) * 1024 + (16 * w + 4 * q) * 4), e2v_ = *(const LAS f32x4*)(lds + L_EV + ((s) & 1) * 1024 + 512 + (16 * w + 4 * q) * 4); \
          const f32x4 fcur = e1v_ * e2prev; e2prev = e2v_; \
          _Pragma("unroll") for (int v2 = 0; v2 < 4; ++v2) { T[v2] = T[v2] * fcur; \
              u32x2 o; o.x = pkbf(T[v2][0], T[v2][1]); o.y = pkbf(T[v2][2], T[v2][3]); \
              *(LAS u32x2*)(lds + L_XT + (16 * v2 + r) * 272 + (16 * w + 4 * q) * 2) = o; } } \
        LDS_BAR(); \
        { LAS unsigned char* ab = lds + L_ATT + ((s) & 1) * 9216; \
            _Pragma("unroll") for (int ks = 0; ks < 2; ++ks) { \
                const bf16x8 a = lds_tr(sb + L_KA + (32 * ks) * 272 + troff272 + (16 * w) * 2, 4 * 272); \
                _Pragma("unroll") for (int v2 = 0; v2 < 4; ++v2) { const bf16x8 bb = lds_tr(sb + L_V + (32 * ks) * 144 + troff144 + (16 * v2) * 2, 4 * 144); T[v2] = MFMA16(a, bb, T[v2]); } } \
            f32x4 o0 = (f32x4){0.f, 0.f, 0.f, 0.f}, o1 = o0; \
            _Pragma("unroll") for (int ks = 0; ks < 2; ++ks) { \
                const bf16x8 a = lds_tr(sb + L_V + (32 * ks) * 144 + troff144 + (16 * vt) * 2, 4 * 144); \
                const bf16x8 b0 = lds16(ab + (16 * tt0) * 144 + rowoff144 + ks * 64); \
                const bf16x8 b1 = lds16(ab + (16 * (tt0 + 1)) * 144 + rowoff144 + ks * 64); \
                o0 = MFMA16(a, b0, o0); o1 = MFMA16(a, b1, o1); } \
            _Pragma("unroll") for (int ks = 0; ks < 4; ++ks) { \
                const bf16x8 a = lds16(lds + L_XT + (16 * vt) * 272 + rowoff272 + ks * 64); \
                const bf16x8 b0 = lds16(sb + L_QA + (16 * tt0) * 272 + rowoff272 + ks * 64); \
                const bf16x8 b1 = lds16(sb + L_QA + (16 * (tt0 + 1)) * 272 + rowoff272 + ks * 64); \
                o0 = MFMA16(a, b0, o0); o1 = MFMA16(a, b1, o1); } \
            u32x2 p0, p1; p0.x = pkbf(o0[0], o0[1]); p0.y = pkbf(o0[2], o0[3]); p1.x = pkbf(o1[0], o1[1]); p1.y = pkbf(o1[2], o1[3]); \
            *(u32x2*)(O + ((size_t)n * 64 + 16 * tt0 + r) * opitch + 16 * vt + 4 * q) = p0; \
            *(u32x2*)(O + ((size_t)n * 64 + 16 * (tt0 + 1) + r) * opitch + 16 * vt + 4 * q) = p1; \
        } \
        SCAN_ATT(((s) + 1) & 1, ((s) + 1) & 1); \
        if (CV) SCAN_CONV((s) >> 1); \
        LDS_BAR(); \
    } while (0)
    for (int s2 = 0; s2 < 64; s2 += 2) { SCAN_STEP(s2, R0, 1); SCAN_STEP(s2 + 1, R1, 0); }
#undef SCAN_ATT
#undef SCAN_CONV
#undef SCAN_STEP
#undef SCAN_LOAD
#undef SCAN_PUT
}
__device__ __forceinline__ void phase3(const Ctx& c, LAS unsigned char* lds) {
    const int G = gridDim.x, bx = blockIdx.x;
    const int vcu = (G % 8 == 0) ? (bx % 8) * (G / 8) + bx / 8 : bx;
    for (int it = vcu; it < 256; it += G) scan_item(c, it, lds);
}

__device__ __forceinline__ void phase4(const Ctx& c) {
    const int tid = threadIdx.x, lane = tid & 63, w = tid >> 6;
    const int gw = blockIdx.x * 8 + w, NGW = gridDim.x * 8;
    const int hh = lane >> 4, dvs = (lane >> 2) & 3, kk = lane & 3;
    float gn[16];
#pragma unroll
    for (int e = 0; e < 16; ++e) gn[e] = c.gng[(lane & 15) * 16 + e];
    for (int m0 = gw * 2; m0 < M; m0 += NGW * 2) {
        u32x4 ra[2][2], rb[2][2], rz[2][2];
#pragma unroll
        for (int rr = 0; rr < 2; ++rr) { const int m = m0 + rr; const int bb = m >> 12, ss = m & 4095;
            const size_t ooff = ((size_t)(((bb * 4 + hh) * 4 + dvs) * 4096 + ss)) * 64 + kk * 16; const size_t zoff = (size_t)m * 1024 + lane * 16;
            ra[rr][0] = __builtin_nontemporal_load((const u32x4*)(c.OF + ooff)); ra[rr][1] = __builtin_nontemporal_load((const u32x4*)(c.OF + ooff + 8));
            rb[rr][0] = *(const u32x4*)(c.Y + (size_t)m * 2048 + lane * 16); rb[rr][1] = *(const u32x4*)(c.Y + (size_t)m * 2048 + lane * 16 + 8);
            rz[rr][0] = __builtin_nontemporal_load((const u32x4*)(c.ZA + zoff)); rz[rr][1] = __builtin_nontemporal_load((const u32x4*)(c.ZA + zoff + 8)); }
#pragma unroll
        for (int rr = 0; rr < 2; ++rr) { const int m = m0 + rr;
            float a[16], bq[16], z[16];
            { float t[8]; unpack8(ra[rr][0], t); for (int e = 0; e < 8; ++e) a[e] = t[e]; unpack8(ra[rr][1], t); for (int e = 0; e < 8; ++e) a[8 + e] = t[e]; }
            { float t[8]; unpack8(rb[rr][0], t); for (int e = 0; e < 8; ++e) bq[e] = t[e]; unpack8(rb[rr][1], t); for (int e = 0; e < 8; ++e) bq[8 + e] = t[e]; }
            { float t[8]; unpack8(rz[rr][0], t); for (int e = 0; e < 8; ++e) z[e] = t[e]; unpack8(rz[rr][1], t); for (int e = 0; e < 8; ++e) z[8 + e] = t[e]; }
            float s = 0.f;
#pragma unroll
            for (int e = 0; e < 16; ++e) { a[e] += bq[e]; s += a[e] * a[e]; }
#pragma unroll
            for (int o = 1; o < 16; o <<= 1) s += __shfl_xor(s, o);
            const float rs = 1.0f / sqrtf(s * (1.0f / 256.0f) + EPS);
            float y[16];
#pragma unroll
            for (int e = 0; e < 16; ++e) y[e] = a[e] * rs * gn[e] * silu_f(z[e]);
            u32x4 o0, o1; o0.x = pkbf(y[0], y[1]); o0.y = pkbf(y[2], y[3]); o0.z = pkbf(y[4], y[5]); o0.w = pkbf(y[6], y[7]);
            o1.x = pkbf(y[8], y[9]); o1.y = pkbf(y[10], y[11]); o1.z = pkbf(y[12], y[13]); o1.w = pkbf(y[14], y[15]);
            *(u32x4*)(c.Y + (size_t)m * 2048 + lane * 16) = o0; *(u32x4*)(c.Y + (size_t)m * 2048 + lane * 16 + 8) = o1; }
    }
}

struct EpiOutNorm {
    static constexpr bool PERM = false, AFTER_DRAIN = false;
    const float* X; float* O; unsigned char* ws; const float* fg;
    __device__ __forceinline__ void operator()(f32x4 (&acc)[2][2][4][2], const pg8::Unit& u, int wr, int wc, int fr, int fq) const {
        float* const ssq = (float*)(ws + WS_SSQ); unsigned* const cnt = (unsigned*)(ws + WS_SSQ + 256 * 1024);
        const int row0 = u.pm * 256 + wr * 64 + fr, col0 = u.pn * 256 + wc * 32 + 4 * fq;
#pragma unroll
        for (int ai = 0; ai < 2; ++ai)
#pragma unroll
            for (int m = 0; m < 4; ++m) { const int row = row0 + ai * 128 + m * 16; const size_t off = (size_t)row * 1024 + col0; float s = 0.f;
#pragma unroll
                for (int bj = 0; bj < 2; ++bj)
#pragma unroll
                    for (int n = 0; n < 2; ++n) { const f32x4 xv = __builtin_nontemporal_load((const f32x4*)(X + off + bj * 128 + n * 16)); const f32x4 o = xv + acc[ai][bj][m][n];
                        acc[ai][bj][m][n] = o; s += (o[0] * o[0] + o[1] * o[1]) + (o[2] * o[2] + o[3] * o[3]); }
                s += __shfl_xor(s, 16); s += __shfl_xor(s, 32);
                if (fq == 0) atomicAdd(ssq + row, s);
                if (m & 1) asm volatile("" ::: "memory"); }
        asm volatile("s_waitcnt vmcnt(0)" ::: "memory");
        unsigned* cw = cnt + (u.pm * 2 + wr) * 64;
        if ((threadIdx.x & 63) == 0) __hip_atomic_fetch_add(cw, 1u, __ATOMIC_RELAXED, __HIP_MEMORY_SCOPE_AGENT);
        unsigned polls = 0;
        while ((unsigned)__builtin_amdgcn_readfirstlane(__hip_atomic_load(cw, __ATOMIC_RELAXED, __HIP_MEMORY_SCOPE_AGENT)) < 16u) { __builtin_amdgcn_s_sleep(2); if (++polls > (1u << 22)) break; }
        asm volatile("" ::: "memory");
#pragma unroll
        for (int ai = 0; ai < 2; ++ai)
#pragma unroll
            for (int m = 0; m < 4; ++m) { const int row = row0 + ai * 128 + m * 16; const size_t off = (size_t)row * 1024 + col0;
                const float rs = 1.0f / sqrtf(__hip_atomic_load(ssq + row, __ATOMIC_RELAXED, __HIP_MEMORY_SCOPE_AGENT) * (1.0f / DM) + EPS);
#pragma unroll
                for (int bj = 0; bj < 2; ++bj)
#pragma unroll
                    for (int n = 0; n < 2; ++n) __builtin_nontemporal_store(acc[ai][bj][m][n] * rs * *(const f32x4*)(fg + col0 + bj * 128 + n * 16), (f32x4*)(O + off + bj * 128 + n * 16));
                asm volatile("" ::: "memory"); }
    }
};
#define XB_TMO      128
#define XB_XCNT(j)  (256  + 64 * (j))
#define XB_XSUB(j)  (1280 + 64 * (j))
#define XB_XGEN(j)  (2304 + 64 * (j))
#define XB_TOP      3328
#define XB_TOPGEN   3392
#define XCD_BAR_WORDS 3456
#define XB_SPIN_CAP (1u << 18)

__device__ __forceinline__ unsigned xb_ld(unsigned* p)              { return __hip_atomic_load(p, __ATOMIC_RELAXED, __HIP_MEMORY_SCOPE_AGENT); }
__device__ __forceinline__ unsigned xb_add(unsigned* p, unsigned v) { return __hip_atomic_fetch_add(p, v, __ATOMIC_RELAXED, __HIP_MEMORY_SCOPE_AGENT); }
__device__ __forceinline__ unsigned xb_xcc_id() { return (unsigned)__builtin_amdgcn_s_getreg((3 << 11) | 20) & 0xFu; }
#define XB_SPIN(cond, bar) do { unsigned _sp = 0; while (cond) { __builtin_amdgcn_s_sleep(1); \
    if ((++_sp & 255u) == 0u) { if (xb_ld(&(bar)[XB_TMO])) break; if (_sp > XB_SPIN_CAP) { atomicAdd(&(bar)[XB_TMO], 1u); break; } } } } while (0)

struct XcdBarrier {
    unsigned* bar; unsigned x;
    volatile LAS unsigned* st;
};

__device__ __forceinline__ XcdBarrier xcd_barrier_post(unsigned* bar, volatile LAS unsigned* st) {
    XcdBarrier b; b.bar = bar; b.x = xb_xcc_id(); b.st = st;
    if (threadIdx.x == 0) (void)xb_add(&bar[XB_XCNT(b.x)], 1u);
    return b;
}
__device__ __forceinline__ void xcd_barrier_complete(unsigned* bar, unsigned x, unsigned& nloc, unsigned& nx) {
    const unsigned G = gridDim.x * gridDim.y * gridDim.z;
    unsigned sum, cnt, mine, sp = 0u;
    for (;;) {
        sum = 0u; cnt = 0u; mine = 0u;
#pragma unroll
        for (unsigned j = 0; j < 16; ++j) { const unsigned c = xb_ld(&bar[XB_XCNT(j)]); sum += c; cnt += (c > 0u) ? 1u : 0u; mine = (j == x) ? c : mine; }
        if (sum == G) break;
        __builtin_amdgcn_s_sleep(1);
        if ((++sp & 255u) == 0u) { if (xb_ld(&bar[XB_TMO])) break; if (sp > XB_SPIN_CAP) { atomicAdd(&bar[XB_TMO], 1u); break; } }
    }
    nloc = mine > 0u ? mine : 1u; nx = cnt > 0u ? cnt : 1u;
}

__device__ __forceinline__ void xcd_barrier(const XcdBarrier& b) {
    asm volatile("s_waitcnt vmcnt(0)" ::: "memory");
    __syncthreads();
    if (threadIdx.x == 0) {
        unsigned* bar = b.bar;
        __builtin_amdgcn_s_waitcnt(0);
        unsigned nloc = b.st[0], nx = b.st[1];
        if (nloc == 0u) { xcd_barrier_complete(bar, b.x, nloc, nx); b.st[0] = nloc; b.st[1] = nx; }
        const unsigned old = xb_add(&bar[XB_XSUB(b.x)], 1u);
        const unsigned gen = old / nloc;
        if (old + 1u == (gen + 1u) * nloc) {
            __builtin_amdgcn_fence(__ATOMIC_RELEASE, "agent");
            asm volatile("s_waitcnt vmcnt(0)" ::: "memory");
            const unsigned og = xb_add(&bar[XB_TOP], 1u);
            const unsigned tg = og / nx;
            if (og + 1u == (tg + 1u) * nx) xb_add(&bar[XB_TOPGEN], 1u);
            else XB_SPIN(xb_ld(&bar[XB_TOPGEN]) == tg, bar);
            __builtin_amdgcn_fence(__ATOMIC_ACQUIRE, "agent");
            xb_add(&bar[XB_XGEN(b.x)], 1u);
            asm volatile("s_waitcnt vmcnt(0)" ::: "memory");
        } else {
            XB_SPIN(xb_ld(&bar[XB_XGEN(b.x)]) == gen, bar);
            __builtin_amdgcn_fence(__ATOMIC_ACQUIRE, "agent");
            asm volatile("s_waitcnt vmcnt(0)" ::: "memory");
        }
    }
    __syncthreads();
}


struct Args { const float* in[12]; float* out; unsigned char* ws; int ph_lo, ph_hi; };
typedef const __attribute__((address_space(4))) Args* KArgs;
__device__ __forceinline__ KArgs kargs() { auto p = __builtin_amdgcn_kernarg_segment_ptr(); asm volatile("" : "+s"(p)); return (KArgs)p; }
__device__ __forceinline__ Ctx make_ctx(KArgs a) {
    Ctx c;
    c.x = a->in[0]; c.norm_g = a->in[1]; c.w_in = a->in[2]; c.wgf = a->in[3]; c.bgf = a->in[4]; c.wgb = a->in[5]; c.bgb = a->in[6];
    c.gng = a->in[7]; c.conv_w = a->in[8]; c.conv_b = a->in[9]; c.w_out = a->in[10]; c.final_g = a->in[11];
    c.out = a->out; unsigned char* ws = a->ws;
    c.ssq = (float*)(ws + WS_SSQ); c.cnt = (unsigned*)(ws + WS_SSQ + 256 * 1024); c.LR = (float*)(ws + WS_LR); c.EV = (float*)(ws + WS_EV);
    c.WOT = (bf16_t*)(ws + WS_WOT); c.WINT = (bf16_t*)(ws + WS_WINT); c.V = (bf16_t*)(ws + WS_V); c.ZA = (bf16_t*)(ws + WS_ZA); c.Y = (bf16_t*)(ws + WS_Y);
    c.Q = (bf16_t*)(ws + WS_Q); c.K = (bf16_t*)(ws + WS_K); c.U = (bf16_t*)(ws + WS_U); c.BZ = (bf16_t*)(ws + WS_BZ);
    c.OF = (bf16_t*)(ws + WS_OF); c.OB = (bf16_t*)(ws + WS_OB);
    unsigned char* ob = (unsigned char*)a->out;
    c.XB = (bf16_t*)ob; c.QAF = (bf16_t*)ob; c.KAF = (bf16_t*)(ob + 32 * MiB); c.QAB = (bf16_t*)(ob + 64 * MiB); c.KAB = (bf16_t*)(ob + 96 * MiB);
    return c;
}
__global__ void __launch_bounds__(512, 2) mk_fwd(Args a) {
    extern __shared__ __attribute__((aligned(16))) unsigned char lds_raw[];
    LAS unsigned char* lds = (LAS unsigned char*)lds_raw;
    const int lo = a.ph_lo, hi = a.ph_hi;
#define IN(k) (lo <= (k) && (k) < hi)
    volatile LAS unsigned* barw = (volatile LAS unsigned*)(lds + L_BARW);
    if (threadIdx.x == 0) { barw[0] = 0u; barw[1] = 0u; }
    __syncthreads();
    (void)xcd_barrier_post((unsigned*)(kargs()->ws + WS_BAR), barw);
    if (lo < 0) cg::this_grid().sync();
#define SEAM(k) do { if (IN(k) && IN((k) + 1)) { XcdBarrier xb_; xb_.bar = (unsigned*)(kargs()->ws + WS_BAR); xb_.x = xb_xcc_id(); xb_.st = barw; xcd_barrier(xb_); } } while (0)
    if (IN(0)) { const Ctx c = make_ctx(kargs()); phase0(c, lds); __syncthreads(); }
    SEAM(0);
    if (IN(1)) {
        KArgs ka = kargs(); unsigned char* ws = ka->ws;
        pg8::Gemm g{(const bf16_t*)ka->out, (const bf16_t*)(ws + WS_WINT), M, NPAD, DM}; pg8::StaticOrder S; S.init(M, NPAD, (int)gridDim.x, (int)blockIdx.x);
        EpiIn E{ws};
        pg8::gemm_phase<EpiIn, pg8::StaticOrder, true, true>(lds, g, S, E);
    }
    SEAM(1);
    if (IN(2)) { const Ctx c = make_ctx(kargs()); phase2(c, lds); }
    SEAM(2);
    if (IN(3)) { const Ctx c = make_ctx(kargs()); phase3(c, lds); }
    SEAM(3);
    if (IN(4)) { const Ctx c = make_ctx(kargs()); phase4(c); }
    SEAM(4);
    if (IN(5)) {
        KArgs ka = kargs(); unsigned char* ws = ka->ws;
        pg8::Gemm g{(const bf16_t*)(ws + WS_Y), (const bf16_t*)(ws + WS_WOT), M, DM, MIXW}; pg8::StaticOrder S; S.init(M, DM, (int)gridDim.x, (int)blockIdx.x);
        EpiOutNorm E{ka->in[0], ka->out, ws, ka->in[11]};
        pg8::gemm_phase<EpiOutNorm, pg8::StaticOrder, true, true>(lds, g, S, E);
    }
#undef IN
#undef SEAM
}

extern "C" void kernel_launch(void* const* d_in, const int* in_sizes, int n_in, void* d_out, int out_size, void* d_ws, size_t ws_size, hipStream_t stream) {
    static int grid = 0;
    if (grid == 0) {
        if (n_in != 12 || out_size != M * DM || ws_size < WS_END) { fprintf(stderr, "kernel_launch: unexpected shapes (n_in %d out %d ws %zu)\n", n_in, out_size, ws_size); grid = -1; return; }
        int dev = 0, cus = 0, per_cu = 0;
        (void)hipGetDevice(&dev); (void)hipDeviceGetAttribute(&cus, hipDeviceAttributeMultiprocessorCount, dev);
        (void)hipFuncSetAttribute((const void*)mk_fwd, hipFuncAttributeMaxDynamicSharedMemorySize, LDS_BYTES);
        (void)hipOccupancyMaxActiveBlocksPerMultiprocessor(&per_cu, (const void*)mk_fwd, 512, LDS_BYTES);
        if (per_cu < 1) per_cu = 1;
        (void)hipGetLastError();
        grid = cus * per_cu;
    }
    if (grid < 0) return;
    Args a{};
    for (int i = 0; i < 12; ++i) a.in[i] = (const float*)d_in[i];
    a.out = (float*)d_out; a.ws = (unsigned char*)d_ws;
#if MK_MULTI
    for (int p = 0; p < NPH; ++p) { a.ph_lo = p; a.ph_hi = p + 1; hipLaunchKernelGGL(mk_fwd, dim3(grid), dim3(512), LDS_BYTES, stream, a);
#ifdef PROBE_DUP
        if (((PROBE_DUP >> p) & 1) && p == 5) (void)hipMemsetAsync((char*)d_ws + WS_SSQ, 0, 512 * 1024, stream);
        if ((PROBE_DUP >> p) & 1) hipLaunchKernelGGL(mk_fwd, dim3(grid), dim3(512), LDS_BYTES, stream, a);
#endif
    }
#else
    a.ph_lo = 0; a.ph_hi = NPH;
    (void)hipMemsetAsync((char*)d_ws + WS_BAR, 0, 3456 * 4, stream);
    void* args[] = {&a};
    hipError_t e = hipLaunchCooperativeKernel((const void*)mk_fwd, dim3(grid), dim3(512), args, LDS_BYTES, stream);
    if (e != hipSuccess) fprintf(stderr, "cooperative launch failed: %s (grid %d)\n", hipGetErrorString(e), grid);
#endif
}
```

```cpp
#include <hip/hip_runtime.h>
#include <hip/hip_cooperative_groups.h>
#include <cstdio>
#include <cstdint>
namespace cg = cooperative_groups;
namespace pg8 {
#define PG8_LAS __attribute__((address_space(3)))
typedef unsigned short bf16_t;
typedef short bf16x8 __attribute__((ext_vector_type(8)));
typedef float f32x4 __attribute__((ext_vector_type(4)));
typedef unsigned u32x4 __attribute__((ext_vector_type(4)));
constexpr int BM = 256, BK = 64, HALF = 128, HTB = HALF * BK * 2  , STAGE_BYTES = 8 * HTB, NXCD = 8, WGM = 8;

__host__ __device__ __forceinline__ int lds_byte(int r, int c) { const int st = (r >> 4) * 2 + (c >> 5), rr = r & 15, cc = c & 31, ob = rr * 64 + cc * 2; return st * 1024 + (ob ^ (((ob >> 9) & 1) << 5)); }
__host__ __device__ __forceinline__ void stage_rc(int b, int& R, int& C) { const int st = b / 1024, sb = b % 1024, swz = sb ^ (((sb >> 9) & 1) << 5); R = (st >> 1) * 16 + swz / 64; C = (st & 1) * 32 + (swz % 64) / 2; }
__host__ __device__ __forceinline__ int perm32(int rho) { const int n = rho >> 4, i = rho & 15; return 8 * (i >> 2) + 4 * n + (i & 3); }

struct Unit { int pm, pn; };
struct Gemm { const bf16_t* A; const bf16_t* Bt; int M, N, K; };

struct StaticOrder {
    int nM, nN, nwg, G, c;
    __host__ __device__ void init(int M, int N, int G_, int c_) { nM = M / BM; nN = N / BM; nwg = nM * nN; G = G_; c = c_; }
    __host__ __device__ bool next(int i, Unit& u) const {
        const long L = (long)i * G + c; if (L >= nwg) return false;
        int wgid = (int)L; { const int q = nwg / NXCD, r = nwg % NXCD, xcd = wgid % NXCD, off = wgid / NXCD; wgid = (xcd < r ? xcd * (q + 1) : r * (q + 1) + (xcd - r) * q) + off; }
        const int nig = WGM * nN, gid = wgid / nig, fm = gid * WGM, gsz = (nM - fm) < WGM ? (nM - fm) : WGM;
        u.pm = fm + ((wgid % nig) % gsz); u.pn = (wgid % nig) / gsz; return true;
    }
    __device__ __forceinline__ void a_ready(const Unit&) const {}
    __device__ __forceinline__ void done(const Unit&) const {}
};

typedef float f32x2 __attribute__((ext_vector_type(2)));
template <class Epi, class Sched, bool ALIGN_EPI = false, bool SP2 = false>
__device__ __forceinline__ void gemm_phase(PG8_LAS unsigned char* lds, const Gemm g, const Sched& S, const Epi& E) {
    const int tid = threadIdx.x, wid = __builtin_amdgcn_readfirstlane(tid >> 6), lane = tid & 63, wr = wid >> 2, wc = wid & 3, fr = lane & 15, fq = lane >> 4;
    const int K = g.K, nt = K / BK;
    unsigned voffA[2], voffB[2];
#pragma unroll
    for (int i = 0; i < 2; ++i) { int R, C; stage_rc(tid * 16 + i * 8192, R, C); const int Rb = Epi::PERM ? ((R & ~31) + perm32(R & 31)) : R;
        voffA[i] = (unsigned)(R * K + C) * 2u; voffB[i] = (unsigned)(Rb * K + C) * 2u; }
    const size_t kstep = (size_t)(BK * 2);
    const size_t hstep = (size_t)HALF * K * 2;
    const size_t tstep = 2 * hstep;
    const unsigned ldsw = (unsigned)wid * 1024u;
    const int aoff = lds_byte(wr * 64 + fr, fq * 8), boff = lds_byte(wc * 32 + fr, fq * 8);
#define PG8_SA(b, h) (((b) * 2 + (h)) * HTB)
#define PG8_SB(b, h) ((4 + (b) * 2 + (h)) * HTB)
#define PG8_STAGE(bufoff, gbase, voff) do { _Pragma("unroll") for (int _i = 0; _i < 2; ++_i) \
        __builtin_amdgcn_global_load_lds((const unsigned*)((const char*)(gbase) + (voff)[_i]), (PG8_LAS unsigned*)(lds + (bufoff) + ldsw + _i * 8192), 16, 0, 0); } while (0)
#define PG8_LDA(dst, b, h) do { _Pragma("unroll") for (int m = 0; m < 4; ++m) _Pragma("unroll") for (int k = 0; k < 2; ++k) dst[m][k] = *(const PG8_LAS bf16x8*)(lds + PG8_SA(b, h) + aoff + m * 2048 + k * 1024); } while (0)
#define PG8_LDB(dst, b, h) do { _Pragma("unroll") for (int n = 0; n < 2; ++n) _Pragma("unroll") for (int k = 0; k < 2; ++k) dst[n][k] = *(const PG8_LAS bf16x8*)(lds + PG8_SB(b, h) + boff + n * 2048 + k * 1024); } while (0)
#define PG8_MMA(ai, bj, At, Bt) do { __builtin_amdgcn_s_setprio(1); _Pragma("unroll") for (int m = 0; m < 4; ++m) _Pragma("unroll") for (int n = 0; n < 2; ++n) _Pragma("unroll") for (int k = 0; k < 2; ++k) \
        acc[ai][bj][m][n] = __builtin_amdgcn_mfma_f32_16x16x32_bf16(Bt[n][k], At[m][k], acc[ai][bj][m][n], 0, 0, 0); __builtin_amdgcn_s_setprio(0); } while (0)
#define PG8_WAIT_V(n) asm volatile("s_waitcnt vmcnt(" #n ")" ::: "memory")
#define PG8_WAIT_L(n) asm volatile("s_waitcnt lgkmcnt(" #n ")" ::: "memory")
#define PG8_BAR __builtin_amdgcn_s_barrier()
#define PG8_SCHED __builtin_amdgcn_sched_barrier(0)
    Unit cur, nxt; int ui = 0;
    if (!S.next(0, cur)) return;
    f32x4 acc[2][2][4][2];
#pragma unroll
    for (int a = 0; a < 2; ++a)
#pragma unroll
        for (int b = 0; b < 2; ++b)
#pragma unroll
            for (int m = 0; m < 4; ++m)
#pragma unroll
                for (int n = 0; n < 2; ++n) acc[a][b][m][n] = (f32x4){0.f, 0.f, 0.f, 0.f};
    bf16x8 At[4][2], B0[2][2], B1[2][2];
    const char* cA = (const char*)g.A + (size_t)cur.pm * tstep; const char* cB = (const char*)g.Bt + (size_t)cur.pn * tstep;
    S.a_ready(cur);
    if constexpr (SP2) {
        PG8_STAGE(PG8_SB(0, 0), cB, voffB); PG8_STAGE(PG8_SB(0, 1), cB + hstep, voffB); PG8_STAGE(PG8_SA(0, 0), cA, voffA); PG8_STAGE(PG8_SA(0, 1), cA + hstep, voffA);
        if (wr == 1) PG8_BAR;
        PG8_WAIT_V(2); PG8_BAR;
        PG8_STAGE(PG8_SB(1, 0), cB + kstep, voffB); PG8_STAGE(PG8_SA(1, 0), cA + kstep, voffA); PG8_STAGE(PG8_SB(1, 1), cB + hstep + kstep, voffB);
        PG8_WAIT_V(6); PG8_BAR;
    } else {
        PG8_STAGE(PG8_SB(0, 0), cB, voffB); PG8_STAGE(PG8_SA(0, 0), cA, voffA); PG8_STAGE(PG8_SB(0, 1), cB + hstep, voffB); PG8_STAGE(PG8_SA(0, 1), cA + hstep, voffA);
        if (wr == 1) PG8_BAR;
        PG8_WAIT_V(4); PG8_BAR;
        PG8_STAGE(PG8_SB(1, 0), cB + kstep, voffB); PG8_STAGE(PG8_SA(1, 0), cA + kstep, voffA); PG8_STAGE(PG8_SB(1, 1), cB + hstep + kstep, voffB);
        PG8_WAIT_V(6); PG8_BAR;
    }
    for (;;) {
        const bool has_next = S.next(ui + 1, nxt);
        const char* nA = has_next ? (const char*)g.A + (size_t)nxt.pm * tstep : cA; const char* nB = has_next ? (const char*)g.Bt + (size_t)nxt.pn * tstep : cB;
        for (int t = 0; t < nt; t += 2) {
            const bool last = (t == nt - 2);
            const char* a1 = cA + (size_t)(t + 1) * kstep;
            const char* a2 = last ? nA : cA + (size_t)(t + 2) * kstep; const char* b2 = last ? nB : cB + (size_t)(t + 2) * kstep;
            const char* a3 = a2 + kstep; const char* b3 = b2 + kstep;
            if (last && has_next) S.a_ready(nxt);
            if constexpr (SP2) {
            PG8_LDB(B0, 0, 0); PG8_LDB(B1, 0, 1); PG8_SCHED; PG8_LDA(At, 0, 0); PG8_STAGE(PG8_SA(1, 1), a1 + hstep, voffA);
            PG8_WAIT_V(8); PG8_WAIT_L(0); PG8_BAR; PG8_MMA(0, 0, At, B0); PG8_MMA(0, 1, At, B1); PG8_BAR; PG8_SCHED;
            PG8_LDA(At, 0, 1); PG8_STAGE(PG8_SB(0, 0), b2, voffB); PG8_STAGE(PG8_SB(0, 1), b2 + hstep, voffB); PG8_STAGE(PG8_SA(0, 0), a2, voffA);
            PG8_WAIT_V(8); PG8_WAIT_L(0); PG8_BAR; PG8_MMA(1, 0, At, B0); PG8_MMA(1, 1, At, B1); PG8_BAR; PG8_SCHED;
            PG8_LDB(B0, 1, 0); PG8_LDB(B1, 1, 1); PG8_SCHED; PG8_LDA(At, 1, 0); PG8_STAGE(PG8_SA(0, 1), a2 + hstep, voffA);
            PG8_WAIT_V(8); PG8_WAIT_L(0); PG8_BAR; PG8_MMA(0, 0, At, B0); PG8_MMA(0, 1, At, B1); PG8_BAR; PG8_SCHED;
            PG8_LDA(At, 1, 1); PG8_STAGE(PG8_SB(1, 0), b3, voffB); PG8_STAGE(PG8_SB(1, 1), b3 + hstep, voffB); PG8_STAGE(PG8_SA(1, 0), a3, voffA);
            PG8_WAIT_V(8); PG8_WAIT_L(0); PG8_BAR; PG8_MMA(1, 0, At, B0); PG8_MMA(1, 1, At, B1); PG8_BAR; PG8_SCHED;
            } else {
            PG8_LDB(B0, 0, 0); PG8_SCHED; PG8_LDA(At, 0, 0); PG8_STAGE(PG8_SA(1, 1), a1 + hstep, voffA);
            PG8_WAIT_L(8); PG8_BAR; PG8_WAIT_L(0); PG8_MMA(0, 0, At, B0); PG8_BAR; PG8_SCHED;
            PG8_LDB(B1, 0, 1); PG8_STAGE(PG8_SB(0, 0), b2, voffB);
            PG8_BAR; PG8_WAIT_L(0); PG8_MMA(0, 1, At, B1); PG8_BAR;
            PG8_LDA(At, 0, 1); PG8_STAGE(PG8_SA(0, 0), a2, voffA);
            PG8_BAR; PG8_WAIT_L(0); PG8_MMA(1, 0, At, B0); PG8_BAR; PG8_SCHED;
            PG8_STAGE(PG8_SB(0, 1), b2 + hstep, voffB);
            PG8_WAIT_V(6); PG8_BAR; PG8_MMA(1, 1, At, B1); PG8_BAR;
            PG8_LDB(B0, 1, 0); PG8_SCHED; PG8_LDA(At, 1, 0); PG8_STAGE(PG8_SA(0, 1), a2 + hstep, voffA);
            PG8_WAIT_L(8); PG8_BAR; PG8_WAIT_L(0); PG8_MMA(0, 0, At, B0); PG8_BAR; PG8_SCHED;
            PG8_LDB(B1, 1, 1); PG8_STAGE(PG8_SB(1, 0), b3, voffB);
            PG8_BAR; PG8_WAIT_L(0); PG8_MMA(0, 1, At, B1); PG8_BAR;
            PG8_LDA(At, 1, 1); PG8_STAGE(PG8_SA(1, 0), a3, voffA);
            PG8_BAR; PG8_WAIT_L(0); PG8_MMA(1, 0, At, B0); PG8_BAR; PG8_SCHED;
            PG8_STAGE(PG8_SB(1, 1), b3 + hstep, voffB);
            PG8_WAIT_V(6); PG8_BAR; PG8_MMA(1, 1, At, B1); PG8_BAR;
            }
        }
        if constexpr (ALIGN_EPI) { if (wr == 0) PG8_BAR; }
        if constexpr (!Epi::AFTER_DRAIN) { E(acc, cur, wr, wc, fr, fq); S.done(cur); }
        if (!has_next) break;
#pragma unroll
        for (int a = 0; a < 2; ++a)
#pragma unroll
            for (int b = 0; b < 2; ++b)
#pragma unroll
                for (int m = 0; m < 4; ++m)
#pragma unroll
                    for (int n = 0; n < 2; ++n) acc[a][b][m][n] = (f32x4){0.f, 0.f, 0.f, 0.f};
        cur = nxt; cA = nA; cB = nB; ++ui;
        if constexpr (ALIGN_EPI) { if (wr == 1) PG8_BAR; }
    }
    PG8_WAIT_V(0);
    if constexpr (!ALIGN_EPI) { if (wr == 0) PG8_BAR; }
    PG8_BAR;
    if constexpr (Epi::AFTER_DRAIN) { E.fused(acc, cur, wr, wc, fr, fq, lds, wid, lane); S.done(cur); }
#undef PG8_SA
#undef PG8_SB
#undef PG8_STAGE
#undef PG8_LDA
#undef PG8_LDB
#undef PG8_MMA
#undef PG8_WAIT_V
#undef PG8_WAIT_L
#undef PG8_BAR
#undef PG8_SCHED
}
}

#ifndef MK_MULTI
#define MK_MULTI 0
#endif
#define LAS __attribute__((address_space(3)))
typedef unsigned short bf16_t;
typedef short bf16x8 __attribute__((ext_vector_type(8)));
typedef float f32x4 __attribute__((ext_vector_type(4)));
typedef float f32x2v __attribute__((ext_vector_type(2)));
typedef unsigned u32x4 __attribute__((ext_vector_type(4)));
typedef unsigned u32x2 __attribute__((ext_vector_type(2)));
#define MFMA16(a, b, c) __builtin_amdgcn_mfma_f32_16x16x32_bf16((a), (b), (c), 0, 0, 0)

constexpr int NB = 8, SEQ = 4096, DM = 1024, M = NB * SEQ;
constexpr int INW = 7200, NPAD = 7424, MIXW = 2048;
constexpr int CH = 64;
constexpr float EPS = 1e-6f;
constexpr int NPH = 6;
constexpr int LDS_BYTES = 158784;
constexpr int L_BARW = 158720;
constexpr size_t WS_BAR = 384 * 1024;
constexpr size_t MiB = (size_t)1 << 20;
constexpr size_t WS_SSQ = 0, WS_WOT = 1 * MiB, WS_LR = 5 * MiB, WS_EV = 9 * MiB, WS_WINT = 13 * MiB;
constexpr size_t WS_V = 32 * MiB, WS_ZA = 96 * MiB, WS_Y = 160 * MiB;
constexpr size_t WS_Q = 288 * MiB, WS_K = 320 * MiB, WS_U = 352 * MiB, WS_BZ = 416 * MiB;
constexpr size_t WS_OF = 288 * MiB, WS_OB = 352 * MiB, WS_END = 481 * MiB;

struct Ctx {
    const float *x, *norm_g, *w_in, *wgf, *bgf, *wgb, *bgb, *gng, *conv_w, *conv_b, *w_out, *final_g;
    float* out; float* ssq; unsigned* cnt; float* LR; float* EV;
    bf16_t *WOT, *WINT, *V, *ZA, *Y, *Q, *K, *U, *BZ, *OF, *OB, *XB, *QAF, *KAF, *QAB, *KAB;
};

typedef __bf16 bf16x2_t __attribute__((ext_vector_type(2)));
__device__ __forceinline__ unsigned pkbf(float lo, float hi) { const f32x2v v = {lo, hi}; const bf16x2_t b = __builtin_convertvector(v, bf16x2_t); return __builtin_bit_cast(unsigned, b); }
__device__ __forceinline__ float bflo(unsigned u) { return __uint_as_float(u << 16); }
__device__ __forceinline__ float bfhi(unsigned u) { return __uint_as_float(u & 0xffff0000u); }
__device__ __forceinline__ float silu_f(float z) { return z * __builtin_amdgcn_rcpf(1.0f + __builtin_amdgcn_exp2f(z * -1.4426950408889634f)); }
__device__ __forceinline__ float wave_sum(float v) {
#pragma unroll
    for (int o = 1; o < 64; o <<= 1) v += __shfl_xor(v, o);
    return v;
}

__device__ __forceinline__ int in_srccol(int nb) {
    const int pn = nb >> 3, wb = nb & 7;
    if (pn < 12) return nb * 32;
    if (pn < 20) { const int j = pn - 12; return wb < 4 ? 4128 + 128 * j + 32 * wb : 5152 + 128 * j + 32 * (wb - 4); }
    if (pn < 28) { const int j = pn - 20; return wb < 4 ? 3104 + 128 * j + 32 * wb : 6176 + 128 * j + 32 * (wb - 4); }
    return wb == 0 ? 3072 : -1;
}
__device__ __forceinline__ void p0_transpose_item(const float* W, int N, int K, bf16_t* WT, int k0, int srccol, int dstrow0, const float* gs, LAS float* scr, int lane) {
    float vv[32], gg[32];
    const int sc_ = srccol >= 0 ? srccol : 0;
#pragma unroll
    for (int i = 0; i < 32; ++i) { const int kk = 2 * i + (lane >> 5); vv[i] = W[(size_t)(k0 + kk) * N + sc_ + (lane & 31)]; gg[i] = gs ? gs[k0 + kk] : 1.0f; }
#pragma unroll
    for (int i = 0; i < 32; ++i) { const int kk = 2 * i + (lane >> 5); scr[kk * 33 + (lane & 31)] = srccol >= 0 ? vv[i] * gg[i] : 0.f; }
    asm volatile("s_waitcnt lgkmcnt(0)" ::: "memory");
    const int c = lane & 7;
#pragma unroll
    for (int j = 0; j < 4; ++j) { const int n = (lane >> 3) + 8 * j; const LAS float* s = scr + (8 * c) * 33 + n;
        u32x4 o; o.x = pkbf(s[0 * 33], s[1 * 33]); o.y = pkbf(s[2 * 33], s[3 * 33]); o.z = pkbf(s[4 * 33], s[5 * 33]); o.w = pkbf(s[6 * 33], s[7 * 33]);
        *(u32x4*)(WT + (size_t)(dstrow0 + n) * K + k0 + 8 * c) = o; }
    asm volatile("s_waitcnt lgkmcnt(0)" ::: "memory");
}
__device__ __forceinline__ void phase0(const Ctx& c, LAS unsigned char* lds) {
    const int tid = threadIdx.x, lane = tid & 63, w = tid >> 6;
    const int gw = blockIdx.x * 8 + w, NGW = gridDim.x * 8;
    LAS float* scr = (LAS float*)(lds + w * 16384);
    constexpr int I_IN = 16 * 232, I_OUT = 32 * 32;
    for (int it = gw; it < I_IN + I_OUT; it += NGW) {
        if (it < I_IN) { const int kb = it / 232, nb = it % 232; p0_transpose_item(c.w_in, INW, DM, c.WINT, 64 * kb, in_srccol(nb), 32 * nb, c.norm_g, scr, lane); }
        else { const int r = it - I_IN, kb = r / 32, nb = r % 32; p0_transpose_item(c.w_out, DM, MIXW, c.WOT, 64 * kb, 32 * nb, 32 * nb, nullptr, scr, lane); }
    }
    for (int i = blockIdx.x * 512 + tid; i < M; i += gridDim.x * 512) c.ssq[i] = 0.f;
    for (int i = blockIdx.x * 512 + tid; i < 256 * 64; i += gridDim.x * 512) c.cnt[i] = 0u;
    for (int m0 = gw * 8; m0 < M; m0 += NGW * 8) {
        f32x4 v[8][4];
#pragma unroll
        for (int rr = 0; rr < 8; ++rr) { const f32x4* xr = (const f32x4*)(c.x + (size_t)(m0 + rr) * DM) + lane;
#pragma unroll
            for (int j = 0; j < 4; ++j) v[rr][j] = __builtin_nontemporal_load(xr + 64 * j); }
#pragma unroll
        for (int rr = 0; rr < 8; ++rr) { float s = 0.f;
#pragma unroll
            for (int j = 0; j < 4; ++j) s += (v[rr][j].x * v[rr][j].x + v[rr][j].y * v[rr][j].y) + (v[rr][j].z * v[rr][j].z + v[rr][j].w * v[rr][j].w);
            const float rstd = 1.0f / sqrtf(wave_sum(s) * (1.0f / DM) + EPS);
            u32x2* o8 = (u32x2*)(c.XB + (size_t)(m0 + rr) * DM) + lane;
#pragma unroll
            for (int j = 0; j < 4; ++j) { u32x2 o; o.x = pkbf(v[rr][j].x * rstd, v[rr][j].y * rstd); o.y = pkbf(v[rr][j].z * rstd, v[rr][j].w * rstd); o8[64 * j] = o; } }
    }
}

struct EpiIn {
    static constexpr bool PERM = true, AFTER_DRAIN = false;
    unsigned char* ws;
    __device__ __forceinline__ void operator()(const f32x4 (&acc)[2][2][4][2], const pg8::Unit& u, int wr, int wc, int fr, int fq) const {
        bf16_t* const Q = (bf16_t*)(ws + WS_Q); bf16_t* const K = (bf16_t*)(ws + WS_K); bf16_t* const V = (bf16_t*)(ws + WS_V); bf16_t* const ZA = (bf16_t*)(ws + WS_ZA);
        bf16_t* const U = (bf16_t*)(ws + WS_U); bf16_t* const BZ = (bf16_t*)(ws + WS_BZ); float* const LR = (float*)(ws + WS_LR);
        const int pn = u.pn; const int row0 = u.pm * 256 + wr * 64 + fr; const int cl = wc * 32 + 8 * fq;
        if (pn >= 4 && pn < 8) {
            const int hh = pn - 4, cs = (wc & 1) * 32 + 8 * fq;
#pragma unroll
            for (int ai = 0; ai < 2; ++ai)
#pragma unroll
                for (int m = 0; m < 4; ++m) { const int row = row0 + ai * 128 + m * 16; const int bb = row >> 12, ss = row & 4095;
#pragma unroll
                    for (int bj = 0; bj < 2; ++bj) { const int dvs = 2 * bj + (wc >> 1); const f32x4 v0 = acc[ai][bj][m][0], v1 = acc[ai][bj][m][1];
                        u32x4 o; o.x = pkbf(v0[0], v0[1]); o.y = pkbf(v0[2], v0[3]); o.z = pkbf(v1[0], v1[1]); o.w = pkbf(v1[2], v1[3]);
                        __builtin_nontemporal_store(o, (u32x4*)(V + ((size_t)(((bb * 4 + hh) * 4 + dvs) * 4096 + ss)) * 64 + cs)); } }
        } else if (pn < 4) {
            bf16_t* base; int pitch, col; float sc = 1.0f;
            if (pn < 2) { base = Q; pitch = 512; col = pn * 256; sc = 0.08838834764831845f; }
            else { base = K; pitch = 512; col = (pn - 2) * 256; }
#pragma unroll
            for (int ai = 0; ai < 2; ++ai)
#pragma unroll
                for (int m = 0; m < 4; ++m) { bf16_t* rowp = base + (size_t)(row0 + ai * 128 + m * 16) * pitch + col + cl;
#pragma unroll
                    for (int bj = 0; bj < 2; ++bj) { const f32x4 v0 = acc[ai][bj][m][0] * sc, v1 = acc[ai][bj][m][1] * sc;
                        u32x4 o; o.x = pkbf(v0[0], v0[1]); o.y = pkbf(v0[2], v0[3]); o.z = pkbf(v1[0], v1[1]); o.w = pkbf(v1[2], v1[3]);
                        __builtin_nontemporal_store(o, (u32x4*)(rowp + bj * 128)); } }
        } else if (pn < 12) {
            const int col = (pn - 8) * 256;
#pragma unroll
            for (int ai = 0; ai < 2; ++ai)
#pragma unroll
                for (int m = 0; m < 4; ++m) { bf16_t* rowp = ZA + (size_t)(row0 + ai * 128 + m * 16) * 1024 + col + cl;
#pragma unroll
                    for (int bj = 0; bj < 2; ++bj) { const f32x4 v0 = acc[ai][bj][m][0], v1 = acc[ai][bj][m][1];
                        u32x4 o; o.x = pkbf(v0[0], v0[1]); o.y = pkbf(v0[2], v0[3]); o.z = pkbf(v1[0], v1[1]); o.w = pkbf(v1[2], v1[3]);
                        __builtin_nontemporal_store(o, (u32x4*)(rowp + bj * 128)); } }
        } else if (pn < 20) {
            const int col = (pn - 12) * 128;
#pragma unroll
            for (int ai = 0; ai < 2; ++ai)
#pragma unroll
                for (int m = 0; m < 4; ++m) { bf16_t* rowp = U + (size_t)(row0 + ai * 128 + m * 16) * 1024 + col + cl;
                    const f32x4 v0 = acc[ai][0][m][0] * acc[ai][1][m][0], v1 = acc[ai][0][m][1] * acc[ai][1][m][1];
                    u32x4 o; o.x = pkbf(v0[0], v0[1]); o.y = pkbf(v0[2], v0[3]); o.z = pkbf(v1[0], v1[1]); o.w = pkbf(v1[2], v1[3]);
                    __builtin_nontemporal_store(o, (u32x4*)rowp); }
        } else if (pn < 28) {
            const int col = (pn - 20) * 128;
#pragma unroll
            for (int ai = 0; ai < 2; ++ai)
#pragma unroll
                for (int m = 0; m < 4; ++m) { bf16_t* rowp = BZ + (size_t)(row0 + ai * 128 + m * 16) * 1024 + col + cl;
                    const f32x4 b0 = acc[ai][0][m][0], b1 = acc[ai][0][m][1], z0 = acc[ai][1][m][0], z1 = acc[ai][1][m][1];
                    u32x4 o; o.x = pkbf(b0[0] * silu_f(z0[0]), b0[1] * silu_f(z0[1])); o.y = pkbf(b0[2] * silu_f(z0[2]), b0[3] * silu_f(z0[3]));
                    o.z = pkbf(b1[0] * silu_f(z1[0]), b1[1] * silu_f(z1[1])); o.w = pkbf(b1[2] * silu_f(z1[2]), b1[3] * silu_f(z1[3]));
                    __builtin_nontemporal_store(o, (u32x4*)rowp); }
        } else {
            if (wc == 0) {
#pragma unroll
                for (int ai = 0; ai < 2; ++ai)
#pragma unroll
                    for (int m = 0; m < 4; ++m) { float* rowp = LR + (size_t)(row0 + ai * 128 + m * 16) * 32 + 8 * fq;
                        *(f32x4*)rowp = acc[ai][0][m][0]; *(f32x4*)(rowp + 4) = acc[ai][0][m][1]; }
            }
        }
    }
};

__device__ __forceinline__ float logsig16(float z) { const float zl = z * 1.4426950408889634f; return (fminf(zl, 0.f) - __builtin_amdgcn_logf(1.0f + __builtin_amdgcn_exp2f(-fabsf(zl)))) * 0.0625f; }
__device__ __forceinline__ void gla_pre_item(const Ctx& c, int item, int next_item, f32x4& lrv, const bf16x8 Aop, const float (&bgv)[2][2], LAS unsigned char* lds) {
    const int h = item & 3, n = (item >> 2) & 63, b = item >> 8;
    const int tid = threadIdx.x, lane = tid & 63, w = __builtin_amdgcn_readfirstlane(tid >> 6);
    const size_t tb = (size_t)b * SEQ + (size_t)n * CH;
    LAS float* lrs = (LAS float*)lds;
    LAS float* tots = (LAS float*)(lds + 8192);
    LAS float* gref = (LAS float*)(lds + 16384);
    const int d = 2 * lane, col = h * 128 + d;
    *(LAS f32x4*)(lrs + tid * 4) = lrv;
    unsigned qu[8], ku[8];
#pragma unroll
    for (int i = 0; i < 8; ++i) { const size_t off = (tb + 8 * w + i) * 512 + col; qu[i] = *(const unsigned*)(c.Q + off); ku[i] = *(const unsigned*)(c.K + off); }
    { const int ni = next_item >= 0 ? next_item : item; const int n2 = (ni >> 2) & 63, b2 = ni >> 8; lrv = *(const f32x4*)(c.LR + ((size_t)b2 * SEQ + (size_t)n2 * CH) * 32 + tid * 4); }
    __syncthreads();
    LAS float* Zs = (LAS float*)(lds + 20480);
    { const int r16 = lane & 15, q = lane >> 4; const u32x4 z4 = {0u, 0u, 0u, 0u}; const f32x4 zero = {0.f, 0.f, 0.f, 0.f};
#pragma unroll
      for (int tt = 0; tt < 4; ++tt) { const LAS float* lr = lrs + (16 * tt + r16) * 32 + 8 * q; const f32x4 l0 = *(const LAS f32x4*)lr, l1 = *(const LAS f32x4*)(lr + 4);
          u32x4 bu; bu.x = pkbf(l0.x, l0.y); bu.y = pkbf(l0.z, l0.w); bu.z = pkbf(l1.x, l1.y); bu.w = pkbf(l1.z, l1.w);
          const u32x4 bfw = q < 2 ? bu : z4, bbw = q < 2 ? z4 : bu;
          const f32x4 zf = MFMA16(Aop, __builtin_bit_cast(bf16x8, bfw), zero), zb = MFMA16(Aop, __builtin_bit_cast(bf16x8, bbw), zero);
          *(LAS f32x4*)(Zs + (size_t)(16 * tt + r16) * 132 + 16 * w + 4 * q) = zf; *(LAS f32x4*)(Zs + (size_t)(64 + 16 * tt + r16) * 132 + 16 * w + 4 * q) = zb; } }
    __syncthreads();
    float g[2][8][2];
#pragma unroll
    for (int dir = 0; dir < 2; ++dir)
#pragma unroll
        for (int i = 0; i < 8; ++i) { const f32x2v z = *(const LAS f32x2v*)(Zs + (size_t)(dir * 64 + 8 * w + i) * 132 + d);
            g[dir][i][0] = logsig16(z.x + bgv[dir][0]); g[dir][i][1] = logsig16(z.y + bgv[dir][1]); }
#pragma unroll
    for (int dd = 0; dd < 2; ++dd) {
        float s = 0.f;
#pragma unroll
        for (int i = 0; i < 8; ++i) { s += g[0][i][dd]; g[0][i][dd] = s; }
        tots[(0 * 8 + w) * 128 + d + dd] = s;
        s = 0.f;
#pragma unroll
        for (int i = 7; i >= 0; --i) { s += g[1][i][dd]; g[1][i][dd] = s; }
        tots[(1 * 8 + w) * 128 + d + dd] = s;
    }
    if (w == 4) { gref[d] = g[0][0][0]; gref[d + 1] = g[0][0][1]; }
    if (w == 3) { gref[128 + d] = g[1][7][0]; gref[128 + d + 1] = g[1][7][1]; }
    __syncthreads();
    float pre[2][2], bref[2][2], ball[2][2];
#pragma unroll
    for (int dd = 0; dd < 2; ++dd) {
        float pf = 0.f, af = 0.f, rf = 0.f, pb = 0.f, ab = 0.f, rb = 0.f;
#pragma unroll
        for (int ww = 0; ww < 8; ++ww) { const float tf = tots[ww * 128 + d + dd], tbk = tots[(8 + ww) * 128 + d + dd];
            af += tf; ab += tbk; if (ww < w) pf += tf; if (ww > w) pb += tbk; if (ww < 4) rf += tf; if (ww > 3) rb += tbk; }
        pre[0][dd] = pf; pre[1][dd] = pb; ball[0][dd] = af; ball[1][dd] = ab;
        bref[0][dd] = rf + gref[d + dd]; bref[1][dd] = rb + gref[128 + d + dd];
    }
    if (w == 0) {
#pragma unroll
        for (int dir = 0; dir < 2; ++dir) { float* ev = c.EV + (size_t)((((b * 4 + h) * 2 + dir) * 64) + n) * 256;
            f32x2v e1; e1.x = __builtin_amdgcn_exp2f(bref[dir][0]); e1.y = __builtin_amdgcn_exp2f(bref[dir][1]);
            f32x2v e2; e2.x = __builtin_amdgcn_exp2f(ball[dir][0] - bref[dir][0]); e2.y = __builtin_amdgcn_exp2f(ball[dir][1] - bref[dir][1]);
            *(f32x2v*)(ev + d) = e1; *(f32x2v*)(ev + 128 + d) = e2; }
    }
    const size_t hb = ((size_t)(b * 4 + h) * SEQ + (size_t)n * CH) * 128 + d;
#pragma unroll
    for (int i = 0; i < 8; ++i) { const size_t off = hb + (size_t)(8 * w + i) * 128;
        const float q0 = bflo(qu[i]), q1 = bfhi(qu[i]), k0 = bflo(ku[i]), k1 = bfhi(ku[i]);
#pragma unroll
        for (int dir = 0; dir < 2; ++dir) {
            const float e0 = __builtin_amdgcn_exp2f(pre[dir][0] + g[dir][i][0] - bref[dir][0]), e1 = __builtin_amdgcn_exp2f(pre[dir][1] + g[dir][i][1] - bref[dir][1]);
            const float r0 = __builtin_amdgcn_rcpf(e0), r1 = __builtin_amdgcn_rcpf(e1);
            *(unsigned*)((dir ? c.QAB : c.QAF) + off) = pkbf(q0 * e0, q1 * e1);
            *(unsigned*)((dir ? c.KAB : c.KAF) + off) = pkbf(k0 * r0, k1 * r1); }
    }
}
__device__ __forceinline__ void unpack8(const u32x4 u, float (&f)[8]) { f[0] = bflo(u.x); f[1] = bfhi(u.x); f[2] = bflo(u.y); f[3] = bfhi(u.y); f[4] = bflo(u.z); f[5] = bfhi(u.z); f[6] = bflo(u.w); f[7] = bfhi(u.w); }
__device__ __forceinline__ void conv_item(const Ctx& c, int cb) {
    const int tid = threadIdx.x, ch = (tid & 127) * 8, tq = tid >> 7;
    float w0[8], w1[8], w2[8], bb[8];
#pragma unroll
    for (int e = 0; e < 8; ++e) { w0[e] = c.conv_w[ch + e]; w1[e] = c.conv_w[1024 + ch + e]; w2[e] = c.conv_w[2048 + ch + e]; bb[e] = c.conv_b[ch + e]; }
    const size_t t0 = (size_t)cb * 64 + 16 * tq; const int pos0 = (int)(t0 % SEQ);
    const u32x4 zero4 = {0u, 0u, 0u, 0u};
    float prev[8], cur[8];
    { u32x4 up = *(const u32x4*)(c.U + (pos0 > 0 ? t0 - 1 : t0) * 1024 + ch); if (pos0 == 0) up = zero4; unpack8(up, prev); }
    unpack8(*(const u32x4*)(c.U + t0 * 1024 + ch), cur);
#pragma unroll
    for (int hb = 0; hb < 2; ++hb) {
        u32x4 un[8], bzr[8];
#pragma unroll
        for (int i = 0; i < 8; ++i) { const size_t t = t0 + 8 * hb + i;
            { const bool inb = (pos0 + 8 * hb + i + 1 < SEQ); un[i] = *(const u32x4*)(c.U + (inb ? t + 1 : t) * 1024 + ch); if (!inb) un[i] = zero4; }
            bzr[i] = *(const u32x4*)(c.BZ + t * 1024 + ch); }
#pragma unroll
        for (int i = 0; i < 8; ++i) { const size_t t = t0 + 8 * hb + i; float nxt[8], bz[8], y[8];
            unpack8(un[i], nxt); unpack8(bzr[i], bz);
#pragma unroll
            for (int e = 0; e < 8; ++e) { y[e] = bz[e] * (w0[e] * prev[e] + w1[e] * cur[e] + w2[e] * nxt[e] + bb[e]); prev[e] = cur[e]; cur[e] = nxt[e]; }
            u32x4 o; o.x = pkbf(y[0], y[1]); o.y = pkbf(y[2], y[3]); o.z = pkbf(y[4], y[5]); o.w = pkbf(y[6], y[7]);
            *(u32x4*)(c.Y + t * 2048 + 1024 + ch) = o; }
    }
}
__device__ __forceinline__ void phase2(const Ctx& c, LAS unsigned char* lds) {
    {
        const int G4 = (int)gridDim.x >> 2, h = (int)blockIdx.x & 3; int p = (int)blockIdx.x >> 2;
        if ((int)blockIdx.x < 4 * G4) {
            const int col = h * 128 + 2 * (threadIdx.x & 63);
            float bgv[2][2];
#pragma unroll
            for (int dir = 0; dir < 2; ++dir) { const float* bg = dir ? c.bgb : c.bgf; const f32x2v bb = *(const f32x2v*)(bg + col); bgv[dir][0] = bb.x; bgv[dir][1] = bb.y; }
            bf16x8 Aop;
            { const int lane_ = threadIdx.x & 63, w_ = __builtin_amdgcn_readfirstlane(threadIdx.x >> 6), q_ = lane_ >> 4; const float* Wsrc = q_ < 2 ? c.wgf : c.wgb;
              const int dcol = h * 128 + 16 * w_ + (lane_ & 15), r0 = 8 * (q_ & 1); float t_[8];
#pragma unroll
              for (int j = 0; j < 8; ++j) t_[j] = Wsrc[(r0 + j) * 512 + dcol];
              u32x4 au; au.x = pkbf(t_[0], t_[1]); au.y = pkbf(t_[2], t_[3]); au.z = pkbf(t_[4], t_[5]); au.w = pkbf(t_[6], t_[7]); Aop = __builtin_bit_cast(bf16x8, au); }
            f32x4 lrv = (f32x4){0.f, 0.f, 0.f, 0.f};
            if (p < 512) { const int n0 = p & 63, b0 = p >> 6; lrv = *(const f32x4*)(c.LR + ((size_t)b0 * SEQ + (size_t)n0 * CH) * 32 + threadIdx.x * 4); }
            for (; p < 512; p += G4) { const int pn = p + G4; gla_pre_item(c, p * 4 + h, pn < 512 ? pn * 4 + h : -1, lrv, Aop, bgv, lds); }
        }
    }
}

constexpr int L_SET = 44032, L_QA = 0, L_KA = 17408, L_V = 34816, L_ATT = 88064  , L_XT = 106496, L_EV = 123904  , L_CV = 125952;
typedef short s16x4 __attribute__((ext_vector_type(4)));
typedef short v4i16_t __attribute__((ext_vector_type(4)));
__device__ __forceinline__ bf16x8 lds16(LAS unsigned char* p) { return *(const LAS bf16x8*)p; }
__device__ __forceinline__ bf16x8 lds_tr(LAS unsigned char* p0, int pitch4) {
    const s16x4 lo = __builtin_bit_cast(s16x4, __builtin_amdgcn_ds_read_tr16_b64_v4i16((LAS v4i16_t*)p0));
    const s16x4 hi = __builtin_bit_cast(s16x4, __builtin_amdgcn_ds_read_tr16_b64_v4i16((LAS v4i16_t*)(p0 + pitch4)));
    return __builtin_shufflevector(lo, hi, 0, 1, 2, 3, 4, 5, 6, 7);
}
#define LDS_BAR() do { asm volatile("s_waitcnt lgkmcnt(0)" ::: "memory"); __builtin_amdgcn_s_barrier(); asm volatile("" ::: "memory"); } while (0)
struct ScanStage { u32x4 q[2], k[2], v, ev, cu0, cu1, cu2, cbz; };
__device__ __forceinline__ void scan_item(const Ctx& c, int item, LAS unsigned char* lds) {
    const int dvs = item & 3, dir = (item >> 2) & 1, h = (item >> 3) & 3, b = item >> 5;
    const int tid = threadIdx.x, lane = tid & 63, w = __builtin_amdgcn_readfirstlane(tid >> 6), r = lane & 15, q = lane >> 4;
    const bf16_t* QA = (dir ? c.QAB : c.QAF) + (size_t)(b * 4 + h) * SEQ * 128;
    const bf16_t* KA = (dir ? c.KAB : c.KAF) + (size_t)(b * 4 + h) * SEQ * 128;
    const bf16_t* Vh = c.V + (size_t)((b * 4 + h) * 4 + dvs) * SEQ * 64;
    bf16_t* O = dir ? c.Y + (size_t)b * SEQ * 2048 + h * 256 + dvs * 64 : c.OF + (size_t)((b * 4 + h) * 4 + dvs) * SEQ * 64;
    const int opitch = dir ? 2048 : 64;
    const float* EV = c.EV + (size_t)(((b * 4 + h) * 2 + dir) * 64) * 256;
    f32x4 T[4];
#pragma unroll
    for (int i = 0; i < 4; ++i) T[i] = (f32x4){0.f, 0.f, 0.f, 0.f};
    ScanStage R0, R1;
    const int cch = (tid & 127) * 8; const size_t ctok0 = (size_t)item * 128 + (tid >> 7);
    f32x4 cw0[2], cw1[2], cw2[2], cwb[2];
#pragma unroll
    for (int e = 0; e < 2; ++e) { cw0[e] = *(const f32x4*)(c.conv_w + cch + 4 * e); cw1[e] = *(const f32x4*)(c.conv_w + 1024 + cch + 4 * e); cw2[e] = *(const f32x4*)(c.conv_w + 2048 + cch + 4 * e); cwb[e] = *(const f32x4*)(c.conv_b + cch + 4 * e); }
    u32x2* const dummy = (u32x2*)((unsigned char*)c.ssq + 480 * MiB) + (size_t)blockIdx.x * 512 + tid;
#define SCAN_LOAD(R, ss, CV) do { const int nn_ = dir ? 63 - (ss) : (ss); \
        (R).q[0] = *(const u32x4*)(QA + (size_t)nn_ * 8192 + tid * 8); (R).q[1] = *(const u32x4*)(QA + (size_t)nn_ * 8192 + 4096 + tid * 8); \
        (R).k[0] = *(const u32x4*)(KA + (size_t)nn_ * 8192 + tid * 8); (R).k[1] = *(const u32x4*)(KA + (size_t)nn_ * 8192 + 4096 + tid * 8); \
        (R).v = *(const u32x4*)(Vh + (size_t)nn_ * 4096 + tid * 8); \
        (R).ev = *(const u32x4*)(EV + (size_t)nn_ * 256 + (tid & 63) * 4); \
        if (CV) { const size_t t_ = ctok0 + 4 * (((ss) - 1) >> 1); const int p_ = (int)(t_ & (SEQ - 1)); \
          (R).cu0 = *(const u32x4*)(c.U + (p_ > 0 ? t_ - 1 : t_) * 1024 + cch); (R).cu1 = *(const u32x4*)(c.U + t_ * 1024 + cch); \
          (R).cu2 = *(const u32x4*)(c.U + (p_ + 1 < SEQ ? t_ + 1 : t_) * 1024 + cch); (R).cbz = *(const u32x4*)(c.BZ + t_ * 1024 + cch); } } while (0)
#define SCAN_PUT(R, set, CV) do { LAS unsigned char* sb_ = lds + (set) * L_SET; \
        *(LAS u32x4*)(sb_ + L_QA + (tid >> 4) * 272 + (tid & 15) * 16) = (R).q[0]; *(LAS u32x4*)(sb_ + L_QA + (32 + (tid >> 4)) * 272 + (tid & 15) * 16) = (R).q[1]; \
        *(LAS u32x4*)(sb_ + L_KA + (tid >> 4) * 272 + (tid & 15) * 16) = (R).k[0]; *(LAS u32x4*)(sb_ + L_KA + (32 + (tid >> 4)) * 272 + (tid & 15) * 16) = (R).k[1]; \
        *(LAS u32x4*)(sb_ + L_V + (tid >> 3) * 144 + (tid & 7) * 16) = (R).v; \
        *(LAS u32x4*)(lds + L_EV + (set) * 1024 + (tid & 63) * 16) = (R).ev;     \
        if (CV) { *(LAS u32x4*)(lds + L_CV + tid * 16) = (R).cu0; *(LAS u32x4*)(lds + L_CV + 8192 + tid * 16) = (R).cu1; *(LAS u32x4*)(lds + L_CV + 16384 + tid * 16) = (R).cu2; *(LAS u32x4*)(lds + L_CV + 24576 + tid * 16) = (R).cbz; } } while (0)
    const int jt = w & 3, tt0 = 2 * (w >> 2), vt = w & 3;
    const int rowoff272 = r * 272 + q * 16, rowoff144 = r * 144 + q * 16;
    const int troff272 = (8 * q + ((lane >> 2) & 3)) * 272 + (lane & 3) * 8, troff144 = (8 * q + ((lane >> 2) & 3)) * 144 + (lane & 3) * 8;
    f32x4 e2prev = (f32x4){1.f, 1.f, 1.f, 1.f};
#define SCAN_ATT(setx, abuf) do { LAS unsigned char* sx_ = lds + (setx) * L_SET; LAS unsigned char* ab_ = lds + L_ATT + (abuf) * 9216; \
        f32x4 c0 = (f32x4){0.f, 0.f, 0.f, 0.f}, c1 = c0; \
        _Pragma("unroll") for (int ks = 0; ks < 4; ++ks) { \
            const bf16x8 a = lds16(sx_ + L_KA + (16 * jt) * 272 + rowoff272 + ks * 64); \
            const bf16x8 b0 = lds16(sx_ + L_QA + (16 * tt0) * 272 + rowoff272 + ks * 64); \
            const bf16x8 b1 = lds16(sx_ + L_QA + (16 * (tt0 + 1)) * 272 + rowoff272 + ks * 64); \
            c0 = MFMA16(a, b0, c0); c1 = MFMA16(a, b1, c1); } \
        const int j0 = 16 * jt + 4 * q; \
        _Pragma("unroll") for (int half = 0; half < 2; ++half) { const int t = 16 * (tt0 + half) + r; const f32x4 cc = half ? c1 : c0; float v[4]; \
            _Pragma("unroll") for (int i = 0; i < 4; ++i) { const int j = j0 + i; const bool keep = dir ? (j > t) : (j <= t); v[i] = keep ? cc[i] : 0.f; } \
            u32x2 o; o.x = pkbf(v[0], v[1]); o.y = pkbf(v[2], v[3]); \
            *(LAS u32x2*)(ab_ + t * 144 + j0 * 2) = o; } } while (0)
#define SCAN_CONV(pi) do { const size_t ct_ = ctok0 + 4 * (pi); const int cpos_ = (int)(ct_ & (SEQ - 1)); \
        u32x4 cup_ = *(const LAS u32x4*)(lds + L_CV + tid * 16); const u32x4 cuc_ = *(const LAS u32x4*)(lds + L_CV + 8192 + tid * 16); \
        u32x4 cun_ = *(const LAS u32x4*)(lds + L_CV + 16384 + tid * 16); const u32x4 cbz_ = *(const LAS u32x4*)(lds + L_CV + 24576 + tid * 16); \
        if (cpos_ == 0) cup_ = (u32x4){0u, 0u, 0u, 0u}; if (cpos_ + 1 >= SEQ) cun_ = (u32x4){0u, 0u, 0u, 0u}; \
        float up_[8], uc_[8], un_[8], bz_[8]; unpack8(cup_, up_); unpack8(cuc_, uc_); unpack8(cun_, un_); unpack8(cbz_, bz_); \
        float y_[8]; \
        _Pragma("unroll") for (int e = 0; e < 8; ++e) y_[e] = bz_[e] * (cw0[e >> 2][e & 3] * up_[e] + cw1[e >> 2][e & 3] * uc_[e] + cw2[e >> 2][e & 3] * un_[e] + cwb[e >> 2][e & 3]); \
        u32x4 yo; yo.x = pkbf(y_[0], y_[1]); yo.y = pkbf(y_[2], y_[3]); yo.z = pkbf(y_[4], y_[5]); yo.w = pkbf(y_[6], y_[7]); \
        *(u32x4*)(c.Y + ct_ * 2048 + 1024 + cch) = yo; } while (0)
    SCAN_LOAD(R0, 0, 0); SCAN_PUT(R0, 0, 0);
    SCAN_LOAD(R0, 1, 1); SCAN_LOAD(R1, 2, 0);
    LDS_BAR();
    SCAN_ATT(0, 0);
#pragma unroll
    for (int k = 0; k < 6; ++k) { asm volatile("" ::: "memory"); *dummy = (u32x2){0u, 0u}; }
    asm volatile("s_waitcnt lgkmcnt(0)" ::: "memory");
#define SCAN_STEP(s, R, CV) do { \
        LAS unsigned char* sb = lds + ((s) & 1) * L_SET; const int n = dir ? 63 - (s) : (s); \
        SCAN_PUT(R, ((s) + 1) & 1, CV); \
        SCAN_LOAD(R, ((s) + 3 < 64 ? (s) + 3 : 63), CV);   \
        { const f32x4 e1v_ = *(const LAS f32x4*)(lds + L_EV + ((s) & 1) * 1024 + (16 * w + 4 * q) * 4), e2v_ = *(const LAS f32x4*)(lds + L_EV + ((s) & 1) * 1024 + 512 + (16 * w + 4 * q) * 4); \
          const f32x4 fcur = e1v_ * e2prev; e2prev = e2v_; \
          _Pragma("unroll") for (int v2 = 0; v2 < 4; ++v2) { T[v2] = T[v2] * fcur; \
              u32x2 o; o.x = pkbf(T[v2][0], T[v2][1]); o.y = pkbf(T[v2][2], T[v2][3]); \
              *(LAS u32x2*)(lds + L_XT + (16 * v2 + r) * 272 + (16 * w + 4 * q) * 2) = o; } } \
        LDS_BAR(); \
        { LAS unsigned char* ab = lds + L_ATT + ((s) & 1) * 9216; \
            _Pragma("unroll") for (int ks = 0; ks < 2; ++ks) { \
                const bf16x8 a = lds_tr(sb + L_KA + (32 * ks) * 272 + troff272 + (16 * w) * 2, 4 * 272); \
                _Pragma("unroll") for (int v2 = 0; v2 < 4; ++v2) { const bf16x8 bb = lds_tr(sb + L_V + (32 * ks) * 144 + troff144 + (16 * v2) * 2, 4 * 144); T[v2] = MFMA16(a, bb, T[v2]); } } \
            f32x4 o0 = (f32x4){0.f, 0.f, 0.f, 0.f}, o1 = o0; \
            _Pragma("unroll") for (int ks = 0; ks < 2; ++ks) { \
                const bf16x8 a = lds_tr(sb + L_V + (32 * ks) * 144 + troff144 + (16 * vt) * 2, 4 * 144); \
                const bf16x8 b0 = lds16(ab + (16 * tt0) * 144 + rowoff144 + ks * 64); \
                const bf16x8 b1 = lds16(ab + (16 * (tt0 + 1)) * 144 + rowoff144 + ks * 64); \
                o0 = MFMA16(a, b0, o0); o1 = MFMA16(a, b1, o1); } \
            _Pragma("unroll") for (int ks = 0; ks < 4; ++ks) { \
                const bf16x8 a = lds16(lds + L_XT + (16 * vt) * 272 + rowoff272 + ks * 64); \
                const bf16x8 b0 = lds16(sb + L_QA + (16 * tt0) * 272 + rowoff272 + ks * 64); \
                const bf16x8 b1 = lds16(sb + L_QA + (16 * (tt0 + 1)) * 272 + rowoff272 + ks * 64); \
                o0 = MFMA16(a, b0, o0); o1 = MFMA16(a, b1, o1); } \
            u32x2 p0, p1; p0.x = pkbf(o0[0], o0[1]); p0.y = pkbf(o0[2], o0[3]); p1.x = pkbf(o1[0], o1[1]); p1.y = pkbf(o1[2], o1[3]); \
            *(u32x2*)(O + ((size_t)n * 64 + 16 * tt0 + r) * opitch + 16 * vt + 4 * q) = p0; \
            *(u32x2*)(O + ((size_t)n * 64 + 16 * (tt0 + 1) + r) * opitch + 16 * vt + 4 * q) = p1; \
        } \
        SCAN_ATT(((s) + 1) & 1, ((s) + 1) & 1); \
        if (CV) SCAN_CONV((s) >> 1); \
        LDS_BAR(); \
    } while (0)
    for (int s2 = 0; s2 < 64; s2 += 2) { SCAN_STEP(s2, R0, 1); SCAN_STEP(s2 + 1, R1, 0); }
#undef SCAN_ATT
#undef SCAN_CONV
#undef SCAN_STEP
#undef SCAN_LOAD
#undef SCAN_PUT
}
__device__ __forceinline__ void phase3(const Ctx& c, LAS unsigned char* lds) {
    const int G = gridDim.x, bx = blockIdx.x;
    const int vcu = (G % 8 == 0) ? (bx % 8) * (G / 8) + bx / 8 : bx;
    for (int it = vcu; it < 256; it += G) scan_item(c, it, lds);
}

__device__ __forceinline__ void phase4(const Ctx& c) {
    const int tid = threadIdx.x, lane = tid & 63, w = tid >> 6;
    const int gw = blockIdx.x * 8 + w, NGW = gridDim.x * 8;
    const int hh = lane >> 4, dvs = (lane >> 2) & 3, kk = lane & 3;
    float gn[16];
#pragma unroll
    for (int e = 0; e < 16; ++e) gn[e] = c.gng[(lane & 15) * 16 + e];
    for (int m0 = gw * 2; m0 < M; m0 += NGW * 2) {
        u32x4 ra[2][2], rb[2][2], rz[2][2];
#pragma unroll
        for (int rr = 0; rr < 2; ++rr) { const int m = m0 + rr; const int bb = m >> 12, ss = m & 4095;
            const size_t ooff = ((size_t)(((bb * 4 + hh) * 4 + dvs) * 4096 + ss)) * 64 + kk * 16; const size_t zoff = (size_t)m * 1024 + lane * 16;
            ra[rr][0] = __builtin_nontemporal_load((const u32x4*)(c.OF + ooff)); ra[rr][1] = __builtin_nontemporal_load((const u32x4*)(c.OF + ooff + 8));
            rb[rr][0] = *(const u32x4*)(c.Y + (size_t)m * 2048 + lane * 16); rb[rr][1] = *(const u32x4*)(c.Y + (size_t)m * 2048 + lane * 16 + 8);
            rz[rr][0] = __builtin_nontemporal_load((const u32x4*)(c.ZA + zoff)); rz[rr][1] = __builtin_nontemporal_load((const u32x4*)(c.ZA + zoff + 8)); }
#pragma unroll
        for (int rr = 0; rr < 2; ++rr) { const int m = m0 + rr;
            float a[16], bq[16], z[16];
            { float t[8]; unpack8(ra[rr][0], t); for (int e = 0; e < 8; ++e) a[e] = t[e]; unpack8(ra[rr][1], t); for (int e = 0; e < 8; ++e) a[8 + e] = t[e]; }
            { float t[8]; unpack8(rb[rr][0], t); for (int e = 0; e < 8; ++e) bq[e] = t[e]; unpack8(rb[rr][1], t); for (int e = 0; e < 8; ++e) bq[8 + e] = t[e]; }
            { float t[8]; unpack8(rz[rr][0], t); for (int e = 0; e < 8; ++e) z[e] = t[e]; unpack8(rz[rr][1], t); for (int e = 0; e < 8; ++e) z[8 + e] = t[e]; }
            float s = 0.f;
#pragma unroll
            for (int e = 0; e < 16; ++e) { a[e] += bq[e]; s += a[e] * a[e]; }
#pragma unroll
            for (int o = 1; o < 16; o <<= 1) s += __shfl_xor(s, o);
            const float rs = 1.0f / sqrtf(s * (1.0f / 256.0f) + EPS);
            float y[16];
#pragma unroll
            for (int e = 0; e < 16; ++e) y[e] = a[e] * rs * gn[e] * silu_f(z[e]);
            u32x4 o0, o1; o0.x = pkbf(y[0], y[1]); o0.y = pkbf(y[2], y[3]); o0.z = pkbf(y[4], y[5]); o0.w = pkbf(y[6], y[7]);
            o1.x = pkbf(y[8], y[9]); o1.y = pkbf(y[10], y[11]); o1.z = pkbf(y[12], y[13]); o1.w = pkbf(y[14], y[15]);
            *(u32x4*)(c.Y + (size_t)m * 2048 + lane * 16) = o0; *(u32x4*)(c.Y + (size_t)m * 2048 + lane * 16 + 8) = o1; }
    }
}

struct EpiOutNorm {
    static constexpr bool PERM = false, AFTER_DRAIN = false;
    const float* X; float* O; unsigned char* ws; const float* fg;
    __device__ __forceinline__ void operator()(f32x4 (&acc)[2][2][4][2], const pg8::Unit& u, int wr, int wc, int fr, int fq) const {
        float* const ssq = (float*)(ws + WS_SSQ); unsigned* const cnt = (unsigned*)(ws + WS_SSQ + 256 * 1024);
        const int row0 = u.pm * 256 + wr * 64 + fr, col0 = u.pn * 256 + wc * 32 + 4 * fq;
#pragma unroll
        for (int ai = 0; ai < 2; ++ai)
#pragma unroll
            for (int m = 0; m < 4; ++m) { const int row = row0 + ai * 128 + m * 16; const size_t off = (size_t)row * 1024 + col0; float s = 0.f;
#pragma unroll
                for (int bj = 0; bj < 2; ++bj)
#pragma unroll
                    for (int n = 0; n < 2; ++n) { const f32x4 xv = __builtin_nontemporal_load((const f32x4*)(X + off + bj * 128 + n * 16)); const f32x4 o = xv + acc[ai][bj][m][n];
                        acc[ai][bj][m][n] = o; s += (o[0] * o[0] + o[1] * o[1]) + (o[2] * o[2] + o[3] * o[3]); }
                s += __shfl_xor(s, 16); s += __shfl_xor(s, 32);
                if (fq == 0) atomicAdd(ssq + row, s);
                if (m & 1) asm volatile("" ::: "memory"); }
        asm volatile("s_waitcnt vmcnt(0)" ::: "memory");
        unsigned* cw = cnt + (u.pm * 2 + wr) * 64;
        if ((threadIdx.x & 63) == 0) __hip_atomic_fetch_add(cw, 1u, __ATOMIC_RELAXED, __HIP_MEMORY_SCOPE_AGENT);
        unsigned polls = 0;
        while ((unsigned)__builtin_amdgcn_readfirstlane(__hip_atomic_load(cw, __ATOMIC_RELAXED, __HIP_MEMORY_SCOPE_AGENT)) < 16u) { __builtin_amdgcn_s_sleep(2); if (++polls > (1u << 22)) break; }
        asm volatile("" ::: "memory");
#pragma unroll
        for (int ai = 0; ai < 2; ++ai)
#pragma unroll
            for (int m = 0; m < 4; ++m) { const int row = row0 + ai * 128 + m * 16; const size_t off = (size_t)row * 1024 + col0;
                const float rs = 1.0f / sqrtf(__hip_atomic_load(ssq + row, __ATOMIC_RELAXED, __HIP_MEMORY_SCOPE_AGENT) * (1.0f / DM) + EPS);
#pragma unroll
                for (int bj = 0; bj < 2; ++bj)
#pragma unroll
                    for (int n = 0; n < 2; ++n) __builtin_nontemporal_store(acc[ai][bj][m][n] * rs * *(const f32x4*)(fg + col0 + bj * 128 + n * 16), (f32x4*)(O + off + bj * 128 + n * 16));
                asm volatile("" ::: "memory"); }
    }
};
#define XB_TMO      128
#define XB_XCNT(j)  (256  + 64 * (j))
#define XB_XSUB(j)  (1280 + 64 * (j))
#define XB_XGEN(j)  (2304 + 64 * (j))
#define XB_TOP      3328
#define XB_TOPGEN   3392
#define XCD_BAR_WORDS 3456
#define XB_SPIN_CAP (1u << 18)

__device__ __forceinline__ unsigned xb_ld(unsigned* p)              { return __hip_atomic_load(p, __ATOMIC_RELAXED, __HIP_MEMORY_SCOPE_AGENT); }
__device__ __forceinline__ unsigned xb_add(unsigned* p, unsigned v) { return __hip_atomic_fetch_add(p, v, __ATOMIC_RELAXED, __HIP_MEMORY_SCOPE_AGENT); }
__device__ __forceinline__ unsigned xb_xcc_id() { return (unsigned)__builtin_amdgcn_s_getreg((3 << 11) | 20) & 0xFu; }
#define XB_SPIN(cond, bar) do { unsigned _sp = 0; while (cond) { __builtin_amdgcn_s_sleep(1); \
    if ((++_sp & 255u) == 0u) { if (xb_ld(&(bar)[XB_TMO])) break; if (_sp > XB_SPIN_CAP) { atomicAdd(&(bar)[XB_TMO], 1u); break; } } } } while (0)

struct XcdBarrier {
    unsigned* bar; unsigned x;
    volatile LAS unsigned* st;
};

__device__ __forceinline__ XcdBarrier xcd_barrier_post(unsigned* bar, volatile LAS unsigned* st) {
    XcdBarrier b; b.bar = bar; b.x = xb_xcc_id(); b.st = st;
    if (threadIdx.x == 0) (void)xb_add(&bar[XB_XCNT(b.x)], 1u);
    return b;
}
__device__ __forceinline__ void xcd_barrier_complete(unsigned* bar, unsigned x, unsigned& nloc, unsigned& nx) {
    const unsigned G = gridDim.x * gridDim.y * gridDim.z;
    unsigned sum, cnt, mine, sp = 0u;
    for (;;) {
        sum = 0u; cnt = 0u; mine = 0u;
#pragma unroll
        for (unsigned j = 0; j < 16; ++j) { const unsigned c = xb_ld(&bar[XB_XCNT(j)]); sum += c; cnt += (c > 0u) ? 1u : 0u; mine = (j == x) ? c : mine; }
        if (sum == G) break;
        __builtin_amdgcn_s_sleep(1);
        if ((++sp & 255u) == 0u) { if (xb_ld(&bar[XB_TMO])) break; if (sp > XB_SPIN_CAP) { atomicAdd(&bar[XB_TMO], 1u); break; } }
    }
    nloc = mine > 0u ? mine : 1u; nx = cnt > 0u ? cnt : 1u;
}

__device__ __forceinline__ void xcd_barrier(const XcdBarrier& b) {
    asm volatile("s_waitcnt vmcnt(0)" ::: "memory");
    __syncthreads();
    if (threadIdx.x == 0) {
        unsigned* bar = b.bar;
        __builtin_amdgcn_s_waitcnt(0);
        unsigned nloc = b.st[0], nx = b.st[1];
        if (nloc == 0u) { xcd_barrier_complete(bar, b.x, nloc, nx); b.st[0] = nloc; b.st[1] = nx; }
        const unsigned old = xb_add(&bar[XB_XSUB(b.x)], 1u);
        const unsigned gen = old / nloc;
        if (old + 1u == (gen + 1u) * nloc) {
            __builtin_amdgcn_fence(__ATOMIC_RELEASE, "agent");
            asm volatile("s_waitcnt vmcnt(0)" ::: "memory");
            const unsigned og = xb_add(&bar[XB_TOP], 1u);
            const unsigned tg = og / nx;
            if (og + 1u == (tg + 1u) * nx) xb_add(&bar[XB_TOPGEN], 1u);
            else XB_SPIN(xb_ld(&bar[XB_TOPGEN]) == tg, bar);
            __builtin_amdgcn_fence(__ATOMIC_ACQUIRE, "agent");
            xb_add(&bar[XB_XGEN(b.x)], 1u);
            asm volatile("s_waitcnt vmcnt(0)" ::: "memory");
        } else {
            XB_SPIN(xb_ld(&bar[XB_XGEN(b.x)]) == gen, bar);
            __builtin_amdgcn_fence(__ATOMIC_ACQUIRE, "agent");
            asm volatile("s_waitcnt vmcnt(0)" ::: "memory");
        }
    }
    __syncthreads();
}


struct Args { const float* in[12]; float* out; unsigned char* ws; int ph_lo, ph_hi; };
typedef const __attribute__((address_space(4))) Args* KArgs;
__device__ __forceinline__ KArgs kargs() { auto p = __builtin_amdgcn_kernarg_segment_ptr(); asm volatile("" : "+s"(p)); return (KArgs)p; }
__device__ __forceinline__ Ctx make_ctx(KArgs a) {
    Ctx c;
    c.x = a->in[0]; c.norm_g = a->in[1]; c.w_in = a->in[2]; c.wgf = a->in[3]; c.bgf = a->in[4]; c.wgb = a->in[5]; c.bgb = a->in[6];
    c.gng = a->in[7]; c.conv_w = a->in[8]; c.conv_b = a->in[9]; c.w_out = a->in[10]; c.final_g = a->in[11];
    c.out = a->out; unsigned char* ws = a->ws;
    c.ssq = (float*)(ws + WS_SSQ); c.cnt = (unsigned*)(ws + WS_SSQ + 256 * 1024); c.LR = (float*)(ws + WS_LR); c.EV = (float*)(ws + WS_EV);
    c.WOT = (bf16_t*)(ws + WS_WOT); c.WINT = (bf16_t*)(ws + WS_WINT); c.V = (bf16_t*)(ws + WS_V); c.ZA = (bf16_t*)(ws + WS_ZA); c.Y = (bf16_t*)(ws + WS_Y);
    c.Q = (bf16_t*)(ws + WS_Q); c.K = (bf16_t*)(ws + WS_K); c.U = (bf16_t*)(ws + WS_U); c.BZ = (bf16_t*)(ws + WS_BZ);
    c.OF = (bf16_t*)(ws + WS_OF); c.OB = (bf16_t*)(ws + WS_OB);
    unsigned char* ob = (unsigned char*)a->out;
    c.XB = (bf16_t*)ob; c.QAF = (bf16_t*)ob; c.KAF = (bf16_t*)(ob + 32 * MiB); c.QAB = (bf16_t*)(ob + 64 * MiB); c.KAB = (bf16_t*)(ob + 96 * MiB);
    return c;
}
__global__ void __launch_bounds__(512, 2) mk_fwd(Args a) {
    extern __shared__ __attribute__((aligned(16))) unsigned char lds_raw[];
    LAS unsigned char* lds = (LAS unsigned char*)lds_raw;
    const int lo = a.ph_lo, hi = a.ph_hi;
#define IN(k) (lo <= (k) && (k) < hi)
    volatile LAS unsigned* barw = (volatile LAS unsigned*)(lds + L_BARW);
    if (threadIdx.x == 0) { barw[0] = 0u; barw[1] = 0u; }
    __syncthreads();
    (void)xcd_barrier_post((unsigned*)(kargs()->ws + WS_BAR), barw);
    if (lo < 0) cg::this_grid().sync();
#define SEAM(k) do { if (IN(k) && IN((k) + 1)) { XcdBarrier xb_; xb_.bar = (unsigned*)(kargs()->ws + WS_BAR); xb_.x = xb_xcc_id(); xb_.st = barw; xcd_barrier(xb_); } } while (0)
    if (IN(0)) { const Ctx c = make_ctx(kargs()); phase0(c, lds); __syncthreads(); }
    SEAM(0);
    if (IN(1)) {
        KArgs ka = kargs(); unsigned char* ws = ka->ws;
        pg8::Gemm g{(const bf16_t*)ka->out, (const bf16_t*)(ws + WS_WINT), M, NPAD, DM}; pg8::StaticOrder S; S.init(M, NPAD, (int)gridDim.x, (int)blockIdx.x);
        EpiIn E{ws};
        pg8::gemm_phase<EpiIn, pg8::StaticOrder, true, true>(lds, g, S, E);
    }
    SEAM(1);
    if (IN(2)) { const Ctx c = make_ctx(kargs()); phase2(c, lds); }
    SEAM(2);
    if (IN(3)) { const Ctx c = make_ctx(kargs()); phase3(c, lds); }
    SEAM(3);
    if (IN(4)) { const Ctx c = make_ctx(kargs()); phase4(c); }
    SEAM(4);
    if (IN(5)) {
        KArgs ka = kargs(); unsigned char* ws = ka->ws;
        pg8::Gemm g{(const bf16_t*)(ws + WS_Y), (const bf16_t*)(ws + WS_WOT), M, DM, MIXW}; pg8::StaticOrder S; S.init(M, DM, (int)gridDim.x, (int)blockIdx.x);
        EpiOutNorm E{ka->in[0], ka->out, ws, ka->in[11]};
        pg8::gemm_phase<EpiOutNorm, pg8::StaticOrder, true, true>(lds, g, S, E);
    }
#undef IN
#undef SEAM
}

extern "C" void kernel_launch(void* const* d_in, const int* in_sizes, int n_in, void* d_out, int out_size, void* d_ws, size_t ws_size, hipStream_t stream) {
    static int grid = 0;
    if (grid == 0) {
        if (n_in != 12 || out_size != M * DM || ws_size < WS_END) { fprintf(stderr, "kernel_launch: unexpected shapes (n_in %d out %d ws %zu)\n", n_in, out_size, ws_size); grid = -1; return; }
        int dev = 0, cus = 0, per_cu = 0;
        (void)hipGetDevice(&dev); (void)hipDeviceGetAttribute(&cus, hipDeviceAttributeMultiprocessorCount, dev);
        (void)hipFuncSetAttribute((const void*)mk_fwd, hipFuncAttributeMaxDynamicSharedMemorySize, LDS_BYTES);
        (void)hipOccupancyMaxActiveBlocksPerMultiprocessor(&per_cu, (const void*)mk_fwd, 512, LDS_BYTES);
        if (per_cu < 1) per_cu = 1;
        (void)hipGetLastError();
        grid = cus * per_cu;
    }
    if (grid < 0) return;
    Args a{};
    for (int i = 0; i < 12; ++i) a.in[i] = (const float*)d_in[i];
    a.out = (float*)d_out; a.ws = (unsigned char*)d_ws;
#if MK_MULTI
    for (int p = 0; p < NPH; ++p) { a.ph_lo = p; a.ph_hi = p + 1; hipLaunchKernelGGL(mk_fwd, dim3(grid), dim3(512), LDS_BYTES, stream, a);
#ifdef PROBE_DUP
        if (((PROBE_DUP >> p) & 1) && p == 5) (void)hipMemsetAsync((char*)d_ws + WS_SSQ, 0, 512 * 1024, stream);
        if ((PROBE_DUP >> p) & 1) hipLaunchKernelGGL(mk_fwd, dim3(grid), dim3(512), LDS_BYTES, stream, a);
#endif
    }
#else
    a.ph_lo = 0; a.ph_hi = NPH;
    (void)hipMemsetAsync((char*)d_ws + WS_BAR, 0, 3456 * 4, stream);
    void* args[] = {&a};
    hipError_t e = hipLaunchCooperativeKernel((const void*)mk_fwd, dim3(grid), dim3(512), args, LDS_BYTES, stream);
    if (e != hipSuccess) fprintf(stderr, "cooperative launch failed: %s (grid %d)\n", hipGetErrorString(e), grid);
#endif
}
```

```cpp
#include <hip/hip_runtime.h>
#include <hip/hip_cooperative_groups.h>
#include <cstdio>
#include <cstdint>
namespace cg = cooperative_groups;
namespace pg8 {
#define PG8_LAS __attribute__((address_space(3)))
typedef unsigned short bf16_t;
typedef short bf16x8 __attribute__((ext_vector_type(8)));
typedef float f32x4 __attribute__((ext_vector_type(4)));
typedef unsigned u32x4 __attribute__((ext_vector_type(4)));
constexpr int BM = 256, BK = 64, HALF = 128, HTB = HALF * BK * 2  , STAGE_BYTES = 8 * HTB, NXCD = 8, WGM = 8;

__host__ __device__ __forceinline__ int lds_byte(int r, int c) { const int st = (r >> 4) * 2 + (c >> 5), rr = r & 15, cc = c & 31, ob = rr * 64 + cc * 2; return st * 1024 + (ob ^ (((ob >> 9) & 1) << 5)); }
__host__ __device__ __forceinline__ void stage_rc(int b, int& R, int& C) { const int st = b / 1024, sb = b % 1024, swz = sb ^ (((sb >> 9) & 1) << 5); R = (st >> 1) * 16 + swz / 64; C = (st & 1) * 32 + (swz % 64) / 2; }
__host__ __device__ __forceinline__ int perm32(int rho) { const int n = rho >> 4, i = rho & 15; return 8 * (i >> 2) + 4 * n + (i & 3); }

struct Unit { int pm, pn; };
struct Gemm { const bf16_t* A; const bf16_t* Bt; int M, N, K; };

struct StaticOrder {
    int nM, nN, nwg, G, c;
    __host__ __device__ void init(int M, int N, int G_, int c_) { nM = M / BM; nN = N / BM; nwg = nM * nN; G = G_; c = c_; }
    __host__ __device__ bool next(int i, Unit& u) const {
        const long L = (long)i * G + c; if (L >= nwg) return false;
        int wgid = (int)L; { const int q = nwg / NXCD, r = nwg % NXCD, xcd = wgid % NXCD, off = wgid / NXCD; wgid = (xcd < r ? xcd * (q + 1) : r * (q + 1) + (xcd - r) * q) + off; }
        const int nig = WGM * nN, gid = wgid / nig, fm = gid * WGM, gsz = (nM - fm) < WGM ? (nM - fm) : WGM;
        u.pm = fm + ((wgid % nig) % gsz); u.pn = (wgid % nig) / gsz; return true;
    }
    __device__ __forceinline__ void a_ready(const Unit&) const {}
    __device__ __forceinline__ void done(const Unit&) const {}
};

typedef float f32x2 __attribute__((ext_vector_type(2)));
template <class Epi, class Sched, bool ALIGN_EPI = false, bool SP2 = false>
__device__ __forceinline__ void gemm_phase(PG8_LAS unsigned char* lds, const Gemm g, const Sched& S, const Epi& E) {
    const int tid = threadIdx.x, wid = __builtin_amdgcn_readfirstlane(tid >> 6), lane = tid & 63, wr = wid >> 2, wc = wid & 3, fr = lane & 15, fq = lane >> 4;
    const int K = g.K, nt = K / BK;
    unsigned voffA[2], voffB[2];
#pragma unroll
    for (int i = 0; i < 2; ++i) { int R, C; stage_rc(tid * 16 + i * 8192, R, C); const int Rb = Epi::PERM ? ((R & ~31) + perm32(R & 31)) : R;
        voffA[i] = (unsigned)(R * K + C) * 2u; voffB[i] = (unsigned)(Rb * K + C) * 2u; }
    const size_t kstep = (size_t)(BK * 2);
    const size_t hstep = (size_t)HALF * K * 2;
    const size_t tstep = 2 * hstep;
    const unsigned ldsw = (unsigned)wid * 1024u;
    const int aoff = lds_byte(wr * 64 + fr, fq * 8), boff = lds_byte(wc * 32 + fr, fq * 8);
#define PG8_SA(b, h) (((b) * 2 + (h)) * HTB)
#define PG8_SB(b, h) ((4 + (b) * 2 + (h)) * HTB)
#define PG8_STAGE(bufoff, gbase, voff) do { _Pragma("unroll") for (int _i = 0; _i < 2; ++_i) \
        __builtin_amdgcn_global_load_lds((const unsigned*)((const char*)(gbase) + (voff)[_i]), (PG8_LAS unsigned*)(lds + (bufoff) + ldsw + _i * 8192), 16, 0, 0); } while (0)
#define PG8_LDA(dst, b, h) do { _Pragma("unroll") for (int m = 0; m < 4; ++m) _Pragma("unroll") for (int k = 0; k < 2; ++k) dst[m][k] = *(const PG8_LAS bf16x8*)(lds + PG8_SA(b, h) + aoff + m * 2048 + k * 1024); } while (0)
#define PG8_LDB(dst, b, h) do { _Pragma("unroll") for (int n = 0; n < 2; ++n) _Pragma("unroll") for (int k = 0; k < 2; ++k) dst[n][k] = *(const PG8_LAS bf16x8*)(lds + PG8_SB(b, h) + boff + n * 2048 + k * 1024); } while (0)
#define PG8_MMA(ai, bj, At, Bt) do { __builtin_amdgcn_s_setprio(1); _Pragma("unroll") for (int m = 0; m < 4; ++m) _Pragma("unroll") for (int n = 0; n < 2; ++n) _Pragma("unroll") for (int k = 0; k < 2; ++k) \
        acc[ai][bj][m][n] = __builtin_amdgcn_mfma_f32_16x16x32_bf16(Bt[n][k], At[m][k], acc[ai][bj][m][n], 0, 0, 0); __builtin_amdgcn_s_setprio(0); } while (0)
#define PG8_WAIT_V(n) asm volatile("s_waitcnt vmcnt(" #n ")" ::: "memory")
#define PG8_WAIT_L(n) asm volatile("s_waitcnt lgkmcnt(" #n ")" ::: "memory")
#define PG8_BAR __builtin_amdgcn_s_barrier()
#define PG8_SCHED __builtin_amdgcn_sched_barrier(0)
    Unit cur, nxt; int ui = 0;
    if (!S.next(0, cur)) return;
    f32x4 acc[2][2][4][2];
#pragma unroll
    for (int a = 0; a < 2; ++a)
#pragma unroll
        for (int b = 0; b < 2; ++b)
#pragma unroll
            for (int m = 0; m < 4; ++m)
#pragma unroll
                for (int n = 0; n < 2; ++n) acc[a][b][m][n] = (f32x4){0.f, 0.f, 0.f, 0.f};
    bf16x8 At[4][2], B0[2][2], B1[2][2];
    const char* cA = (const char*)g.A + (size_t)cur.pm * tstep; const char* cB = (const char*)g.Bt + (size_t)cur.pn * tstep;
    S.a_ready(cur);
    if constexpr (SP2) {
        PG8_STAGE(PG8_SB(0, 0), cB, voffB); PG8_STAGE(PG8_SB(0, 1), cB + hstep, voffB); PG8_STAGE(PG8_SA(0, 0), cA, voffA); PG8_STAGE(PG8_SA(0, 1), cA + hstep, voffA);
        if (wr == 1) PG8_BAR;
        PG8_WAIT_V(2); PG8_BAR;
        PG8_STAGE(PG8_SB(1, 0), cB + kstep, voffB); PG8_STAGE(PG8_SA(1, 0), cA + kstep, voffA); PG8_STAGE(PG8_SB(1, 1), cB + hstep + kstep, voffB);
        PG8_WAIT_V(6); PG8_BAR;
    } else {
        PG8_STAGE(PG8_SB(0, 0), cB, voffB); PG8_STAGE(PG8_SA(0, 0), cA, voffA); PG8_STAGE(PG8_SB(0, 1), cB + hstep, voffB); PG8_STAGE(PG8_SA(0, 1), cA + hstep, voffA);
        if (wr == 1) PG8_BAR;
        PG8_WAIT_V(4); PG8_BAR;
        PG8_STAGE(PG8_SB(1, 0), cB + kstep, voffB); PG8_STAGE(PG8_SA(1, 0), cA + kstep, voffA); PG8_STAGE(PG8_SB(1, 1), cB + hstep + kstep, voffB);
        PG8_WAIT_V(6); PG8_BAR;
    }
    for (;;) {
        const bool has_next = S.next(ui + 1, nxt);
        const char* nA = has_next ? (const char*)g.A + (size_t)nxt.pm * tstep : cA; const char* nB = has_next ? (const char*)g.Bt + (size_t)nxt.pn * tstep : cB;
        for (int t = 0; t < nt; t += 2) {
            const bool last = (t == nt - 2);
            const char* a1 = cA + (size_t)(t + 1) * kstep;
            const char* a2 = last ? nA : cA + (size_t)(t + 2) * kstep; const char* b2 = last ? nB : cB + (size_t)(t + 2) * kstep;
            const char* a3 = a2 + kstep; const char* b3 = b2 + kstep;
            if (last && has_next) S.a_ready(nxt);
            if constexpr (SP2) {
            PG8_LDB(B0, 0, 0); PG8_LDB(B1, 0, 1); PG8_SCHED; PG8_LDA(At, 0, 0); PG8_STAGE(PG8_SA(1, 1), a1 + hstep, voffA);
            PG8_WAIT_V(8); PG8_WAIT_L(0); PG8_BAR; PG8_MMA(0, 0, At, B0); PG8_MMA(0, 1, At, B1); PG8_BAR; PG8_SCHED;
            PG8_LDA(At, 0, 1); PG8_STAGE(PG8_SB(0, 0), b2, voffB); PG8_STAGE(PG8_SB(0, 1), b2 + hstep, voffB); PG8_STAGE(PG8_SA(0, 0), a2, voffA);
            PG8_WAIT_V(8); PG8_WAIT_L(0); PG8_BAR; PG8_MMA(1, 0, At, B0); PG8_MMA(1, 1, At, B1); PG8_BAR; PG8_SCHED;
            PG8_LDB(B0, 1, 0); PG8_LDB(B1, 1, 1); PG8_SCHED; PG8_LDA(At, 1, 0); PG8_STAGE(PG8_SA(0, 1), a2 + hstep, voffA);
            PG8_WAIT_V(8); PG8_WAIT_L(0); PG8_BAR; PG8_MMA(0, 0, At, B0); PG8_MMA(0, 1, At, B1); PG8_BAR; PG8_SCHED;
            PG8_LDA(At, 1, 1); PG8_STAGE(PG8_SB(1, 0), b3, voffB); PG8_STAGE(PG8_SB(1, 1), b3 + hstep, voffB); PG8_STAGE(PG8_SA(1, 0), a3, voffA);
            PG8_WAIT_V(8); PG8_WAIT_L(0); PG8_BAR; PG8_MMA(1, 0, At, B0); PG8_MMA(1, 1, At, B1); PG8_BAR; PG8_SCHED;
            } else {
            PG8_LDB(B0, 0, 0); PG8_SCHED; PG8_LDA(At, 0, 0); PG8_STAGE(PG8_SA(1, 1), a1 + hstep, voffA);
            PG8_WAIT_L(8); PG8_BAR; PG8_WAIT_L(0); PG8_MMA(0, 0, At, B0); PG8_BAR; PG8_SCHED;
            PG8_LDB(B1, 0, 1); PG8_STAGE(PG8_SB(0, 0), b2, voffB);
            PG8_BAR; PG8_WAIT_L(0); PG8_MMA(0, 1, At, B1); PG8_BAR;
            PG8_LDA(At, 0, 1); PG8_STAGE(PG8_SA(0, 0), a2, voffA);
            PG8_BAR; PG8_WAIT_L(0); PG8_MMA(1, 0, At, B0); PG8_BAR; PG8_SCHED;
            PG8_STAGE(PG8_SB(0, 1), b2 + hstep, voffB);
            PG8_WAIT_V(6); PG8_BAR; PG8_MMA(1, 1, At, B1); PG8_BAR;
            PG8_LDB(B0, 1, 0); PG8_SCHED; PG8_LDA(At, 1, 0); PG8_STAGE(PG8_SA(0, 1), a2 + hstep, voffA);
            PG8_WAIT_L(8); PG8_BAR; PG8_WAIT_L(0); PG8_MMA(0, 0, At, B0); PG8_BAR; PG8_SCHED;
            PG8_LDB(B1, 1, 1); PG8_STAGE(PG8_SB(1, 0), b3, voffB);
            PG8_BAR; PG8_WAIT_L(0); PG8_MMA(0, 1, At, B1); PG8_BAR;
            PG8_LDA(At, 1, 1); PG8_STAGE(PG8_SA(1, 0), a3, voffA);
            PG8_BAR; PG8_WAIT_L(0); PG8_MMA(1, 0, At, B0); PG8_BAR; PG8_SCHED;
            PG8_STAGE(PG8_SB(1, 1), b3 + hstep, voffB);
            PG8_WAIT_V(6); PG8_BAR; PG8_MMA(1, 1, At, B1); PG8_BAR;
            }
        }
        if constexpr (ALIGN_EPI) { if (wr == 0) PG8_BAR; }
        if constexpr (!Epi::AFTER_DRAIN) { E(acc, cur, wr, wc, fr, fq); S.done(cur); }
        if (!has_next) break;
#pragma unroll
        for (int a = 0; a < 2; ++a)
#pragma unroll
            for (int b = 0; b < 2; ++b)
#pragma unroll
                for (int m = 0; m < 4; ++m)
#pragma unroll
                    for (int n = 0; n < 2; ++n) acc[a][b][m][n] = (f32x4){0.f, 0.f, 0.f, 0.f};
        cur = nxt; cA = nA; cB = nB; ++ui;
        if constexpr (ALIGN_EPI) { if (wr == 1) PG8_BAR; }
    }
    PG8_WAIT_V(0);
    if constexpr (!ALIGN_EPI) { if (wr == 0) PG8_BAR; }
    PG8_BAR;
    if constexpr (Epi::AFTER_DRAIN) { E.fused(acc, cur, wr, wc, fr, fq, lds, wid, lane); S.done(cur); }
#undef PG8_SA
#undef PG8_SB
#undef PG8_STAGE
#undef PG8_LDA
#undef PG8_LDB
#undef PG8_MMA
#undef PG8_WAIT_V
#undef PG8_WAIT_L
#undef PG8_BAR
#undef PG8_SCHED
}
}

#ifndef MK_MULTI
#define MK_MULTI 0
#endif
#define LAS __attribute__((address_space(3)))
typedef unsigned short bf16_t;
typedef short bf16x8 __attribute__((ext_vector_type(8)));
typedef float f32x4 __attribute__((ext_vector_type(4)));
typedef float f32x2v __attribute__((ext_vector_type(2)));
typedef unsigned u32x4 __attribute__((ext_vector_type(4)));
typedef unsigned u32x2 __attribute__((ext_vector_type(2)));
#define MFMA16(a, b, c) __builtin_amdgcn_mfma_f32_16x16x32_bf16((a), (b), (c), 0, 0, 0)

constexpr int NB = 8, SEQ = 4096, DM = 1024, M = NB * SEQ;
constexpr int INW = 7200, NPAD = 7424, MIXW = 2048;
constexpr int CH = 64;
constexpr float EPS = 1e-6f;
constexpr int NPH = 6;
constexpr int LDS_BYTES = 158784;
constexpr int L_BARW = 158720;
constexpr size_t WS_BAR = 384 * 1024;
constexpr size_t MiB = (size_t)1 << 20;
constexpr size_t WS_SSQ = 0, WS_WOT = 1 * MiB, WS_LR = 5 * MiB, WS_EV = 9 * MiB, WS_WINT = 13 * MiB;
constexpr size_t WS_V = 32 * MiB, WS_ZA = 96 * MiB, WS_Y = 160 * MiB;
constexpr size_t WS_Q = 288 * MiB, WS_K = 320 * MiB, WS_U = 352 * MiB, WS_BZ = 416 * MiB;
constexpr size_t WS_OF = 288 * MiB, WS_OB = 352 * MiB, WS_END = 481 * MiB;

struct Ctx {
    const float *x, *norm_g, *w_in, *wgf, *bgf, *wgb, *bgb, *gng, *conv_w, *conv_b, *w_out, *final_g;
    float* out; float* ssq; unsigned* cnt; float* LR; float* EV;
    bf16_t *WOT, *WINT, *V, *ZA, *Y, *Q, *K, *U, *BZ, *OF, *OB, *XB, *QAF, *KAF, *QAB, *KAB;
};

typedef __bf16 bf16x2_t __attribute__((ext_vector_type(2)));
__device__ __forceinline__ unsigned pkbf(float lo, float hi) { const f32x2v v = {lo, hi}; const bf16x2_t b = __builtin_convertvector(v, bf16x2_t); return __builtin_bit_cast(unsigned, b); }
__device__ __forceinline__ float bflo(unsigned u) { return __uint_as_float(u << 16); }
__device__ __forceinline__ float bfhi(unsigned u) { return __uint_as_float(u & 0xffff0000u); }
__device__ __forceinline__ float silu_f(float z) { return z * __builtin_amdgcn_rcpf(1.0f + __builtin_amdgcn_exp2f(z * -1.4426950408889634f)); }
__device__ __forceinline__ float wave_sum(float v) {
#pragma unroll
    for (int o = 1; o < 64; o <<= 1) v += __shfl_xor(v, o);
    return v;
}

__device__ __forceinline__ int in_srccol(int nb) {
    const int pn = nb >> 3, wb = nb & 7;
    if (pn < 12) return nb * 32;
    if (pn < 20) { const int j = pn - 12; return wb < 4 ? 4128 + 128 * j + 32 * wb : 5152 + 128 * j + 32 * (wb - 4); }
    if (pn < 28) { const int j = pn - 20; return wb < 4 ? 3104 + 128 * j + 32 * wb : 6176 + 128 * j + 32 * (wb - 4); }
    return wb == 0 ? 3072 : -1;
}
__device__ __forceinline__ void p0_transpose_item(const float* W, int N, int K, bf16_t* WT, int k0, int srccol, int dstrow0, const float* gs, LAS float* scr, int lane) {
    float vv[32], gg[32];
    const int sc_ = srccol >= 0 ? srccol : 0;
#pragma unroll
    for (int i = 0; i < 32; ++i) { const int kk = 2 * i + (lane >> 5); vv[i] = W[(size_t)(k0 + kk) * N + sc_ + (lane & 31)]; gg[i] = gs ? gs[k0 + kk] : 1.0f; }
#pragma unroll
    for (int i = 0; i < 32; ++i) { const int kk = 2 * i + (lane >> 5); scr[kk * 33 + (lane & 31)] = srccol >= 0 ? vv[i] * gg[i] : 0.f; }
    asm volatile("s_waitcnt lgkmcnt(0)" ::: "memory");
    const int c = lane & 7;
#pragma unroll
    for (int j = 0; j < 4; ++j) { const int n = (lane >> 3) + 8 * j; const LAS float* s = scr + (8 * c) * 33 + n;
        u32x4 o; o.x = pkbf(s[0 * 33], s[1 * 33]); o.y = pkbf(s[2 * 33], s[3 * 33]); o.z = pkbf(s[4 * 33], s[5 * 33]); o.w = pkbf(s[6 * 33], s[7 * 33]);
        *(u32x4*)(WT + (size_t)(dstrow0 + n) * K + k0 + 8 * c) = o; }
    asm volatile("s_waitcnt lgkmcnt(0)" ::: "memory");
}
__device__ __forceinline__ void phase0(const Ctx& c, LAS unsigned char* lds) {
    const int tid = threadIdx.x, lane = tid & 63, w = tid >> 6;
    const int gw = blockIdx.x * 8 + w, NGW = gridDim.x * 8;
    LAS float* scr = (LAS float*)(lds + w * 16384);
    constexpr int I_IN = 16 * 232, I_OUT = 32 * 32;
    for (int it = gw; it < I_IN + I_OUT; it += NGW) {
        if (it < I_IN) { const int kb = it / 232, nb = it % 232; p0_transpose_item(c.w_in, INW, DM, c.WINT, 64 * kb, in_srccol(nb), 32 * nb, c.norm_g, scr, lane); }
        else { const int r = it - I_IN, kb = r / 32, nb = r % 32; p0_transpose_item(c.w_out, DM, MIXW, c.WOT, 64 * kb, 32 * nb, 32 * nb, nullptr, scr, lane); }
    }
    for (int i = blockIdx.x * 512 + tid; i < M; i += gridDim.x * 512) c.ssq[i] = 0.f;
    for (int i = blockIdx.x * 512 + tid; i < 256 * 64; i += gridDim.x * 512) c.cnt[i] = 0u;
    for (int m0 = gw * 8; m0 < M; m0 += NGW * 8) {
        f32x4 v[8][4];
#pragma unroll
        for (int rr = 0; rr < 8; ++rr) { const f32x4* xr = (const f32x4*)(c.x + (size_t)(m0 + rr) * DM) + lane;
#pragma unroll
            for (int j = 0; j < 4; ++j) v[rr][j] = __builtin_nontemporal_load(xr + 64 * j); }
#pragma unroll
        for (int rr = 0; rr < 8; ++rr) { float s = 0.f;
#pragma unroll
            for (int j = 0; j < 4; ++j) s += (v[rr][j].x * v[rr][j].x + v[rr][j].y * v[rr][j].y) + (v[rr][j].z * v[rr][j].z + v[rr][j].w * v[rr][j].w);
            const float rstd = 1.0f / sqrtf(wave_sum(s) * (1.0f / DM) + EPS);
            u32x2* o8 = (u32x2*)(c.XB + (size_t)(m0 + rr) * DM) + lane;
#pragma unroll
            for (int j = 0; j < 4; ++j) { u32x2 o; o.x = pkbf(v[rr][j].x * rstd, v[rr][j].y * rstd); o.y = pkbf(v[rr][j].z * rstd, v[rr][j].w * rstd); o8[64 * j] = o; } }
    }
}

struct EpiIn {
    static constexpr bool PERM = true, AFTER_DRAIN = false;
    unsigned char* ws;
    __device__ __forceinline__ void operator()(const f32x4 (&acc)[2][2][4][2], const pg8::Unit& u, int wr, int wc, int fr, int fq) const {
        bf16_t* const Q = (bf16_t*)(ws + WS_Q); bf16_t* const K = (bf16_t*)(ws + WS_K); bf16_t* const V = (bf16_t*)(ws + WS_V); bf16_t* const ZA = (bf16_t*)(ws + WS_ZA);
        bf16_t* const U = (bf16_t*)(ws + WS_U); bf16_t* const BZ = (bf16_t*)(ws + WS_BZ); float* const LR = (float*)(ws + WS_LR);
        const int pn = u.pn; const int row0 = u.pm * 256 + wr * 64 + fr; const int cl = wc * 32 + 8 * fq;
        if (pn >= 4 && pn < 8) {
            const int hh = pn - 4, cs = (wc & 1) * 32 + 8 * fq;
#pragma unroll
            for (int ai = 0; ai < 2; ++ai)
#pragma unroll
                for (int m = 0; m < 4; ++m) { const int row = row0 + ai * 128 + m * 16; const int bb = row >> 12, ss = row & 4095;
#pragma unroll
                    for (int bj = 0; bj < 2; ++bj) { const int dvs = 2 * bj + (wc >> 1); const f32x4 v0 = acc[ai][bj][m][0], v1 = acc[ai][bj][m][1];
                        u32x4 o; o.x = pkbf(v0[0], v0[1]); o.y = pkbf(v0[2], v0[3]); o.z = pkbf(v1[0], v1[1]); o.w = pkbf(v1[2], v1[3]);
                        __builtin_nontemporal_store(o, (u32x4*)(V + ((size_t)(((bb * 4 + hh) * 4 + dvs) * 4096 + ss)) * 64 + cs)); } }
        } else if (pn < 4) {
            bf16_t* base; int pitch, col; float sc = 1.0f;
            if (pn < 2) { base = Q; pitch = 512; col = pn * 256; sc = 0.08838834764831845f; }
            else { base = K; pitch = 512; col = (pn - 2) * 256; }
#pragma unroll
            for (int ai = 0; ai < 2; ++ai)
#pragma unroll
                for (int m = 0; m < 4; ++m) { bf16_t* rowp = base + (size_t)(row0 + ai * 128 + m * 16) * pitch + col + cl;
#pragma unroll
                    for (int bj = 0; bj < 2; ++bj) { const f32x4 v0 = acc[ai][bj][m][0] * sc, v1 = acc[ai][bj][m][1] * sc;
                        u32x4 o; o.x = pkbf(v0[0], v0[1]); o.y = pkbf(v0[2], v0[3]); o.z = pkbf(v1[0], v1[1]); o.w = pkbf(v1[2], v1[3]);
                        __builtin_nontemporal_store(o, (u32x4*)(rowp + bj * 128)); } }
        } else if (pn < 12) {
            const int col = (pn - 8) * 256;
#pragma unroll
            for (int ai = 0; ai < 2; ++ai)
#pragma unroll
                for (int m = 0; m < 4; ++m) { bf16_t* rowp = ZA + (size_t)(row0 + ai * 128 + m * 16) * 1024 + col + cl;
#pragma unroll
                    for (int bj = 0; bj < 2; ++bj) { const f32x4 v0 = acc[ai][bj][m][0], v1 = acc[ai][bj][m][1];
                        u32x4 o; o.x = pkbf(v0[0], v0[1]); o.y = pkbf(v0[2], v0[3]); o.z = pkbf(v1[0], v1[1]); o.w = pkbf(v1[2], v1[3]);
                        __builtin_nontemporal_store(o, (u32x4*)(rowp + bj * 128)); } }
        } else if (pn < 20) {
            const int col = (pn - 12) * 128;
#pragma unroll
            for (int ai = 0; ai < 2; ++ai)
#pragma unroll
                for (int m = 0; m < 4; ++m) { bf16_t* rowp = U + (size_t)(row0 + ai * 128 + m * 16) * 1024 + col + cl;
                    const f32x4 v0 = acc[ai][0][m][0] * acc[ai][1][m][0], v1 = acc[ai][0][m][1] * acc[ai][1][m][1];
                    u32x4 o; o.x = pkbf(v0[0], v0[1]); o.y = pkbf(v0[2], v0[3]); o.z = pkbf(v1[0], v1[1]); o.w = pkbf(v1[2], v1[3]);
                    __builtin_nontemporal_store(o, (u32x4*)rowp); }
        } else if (pn < 28) {
            const int col = (pn - 20) * 128;
#pragma unroll
            for (int ai = 0; ai < 2; ++ai)
#pragma unroll
                for (int m = 0; m < 4; ++m) { bf16_t* rowp = BZ + (size_t)(row0 + ai * 128 + m * 16) * 1024 + col + cl;
                    const f32x4 b0 = acc[ai][0][m][0], b1 = acc[ai][0][m][1], z0 = acc[ai][1][m][0], z1 = acc[ai][1][m][1];
                    u32x4 o; o.x = pkbf(b0[0] * silu_f(z0[0]), b0[1] * silu_f(z0[1])); o.y = pkbf(b0[2] * silu_f(z0[2]), b0[3] * silu_f(z0[3]));
                    o.z = pkbf(b1[0] * silu_f(z1[0]), b1[1] * silu_f(z1[1])); o.w = pkbf(b1[2] * silu_f(z1[2]), b1[3] * silu_f(z1[3]));
                    __builtin_nontemporal_store(o, (u32x4*)rowp); }
        } else {
            if (wc == 0) {
#pragma unroll
                for (int ai = 0; ai < 2; ++ai)
#pragma unroll
                    for (int m = 0; m < 4; ++m) { float* rowp = LR + (size_t)(row0 + ai * 128 + m * 16) * 32 + 8 * fq;
                        *(f32x4*)rowp = acc[ai][0][m][0]; *(f32x4*)(rowp + 4) = acc[ai][0][m][1]; }
            }
        }
    }
};

__device__ __forceinline__ float logsig16(float z) { const float zl = z * 1.4426950408889634f; return (fminf(zl, 0.f) - __builtin_amdgcn_logf(1.0f + __builtin_amdgcn_exp2f(-fabsf(zl)))) * 0.0625f; }
__device__ __forceinline__ void gla_pre_item(const Ctx& c, int item, int next_item, f32x4& lrv, const bf16x8 Aop, const float (&bgv)[2][2], LAS unsigned char* lds) {
    const int h = item & 3, n = (item >> 2) & 63, b = item >> 8;
    const int tid = threadIdx.x, lane = tid & 63, w = __builtin_amdgcn_readfirstlane(tid >> 6);
    const size_t tb = (size_t)b * SEQ + (size_t)n * CH;
    LAS float* lrs = (LAS float*)lds;
    LAS float* tots = (LAS float*)(lds + 8192);
    LAS float* gref = (LAS float*)(lds + 16384);
    const int d = 2 * lane, col = h * 128 + d;
    *(LAS f32x4*)(lrs + tid * 4) = lrv;
    unsigned qu[8], ku[8];
#pragma unroll
    for (int i = 0; i < 8; ++i) { const size_t off = (tb + 8 * w + i) * 512 + col; qu[i] = *(const unsigned*)(c.Q + off); ku[i] = *(const unsigned*)(c.K + off); }
    { const int ni = next_item >= 0 ? next_item : item; const int n2 = (ni >> 2) & 63, b2 = ni >> 8; lrv = *(const f32x4*)(c.LR + ((size_t)b2 * SEQ + (size_t)n2 * CH) * 32 + tid * 4); }
    __syncthreads();
    LAS float* Zs = (LAS float*)(lds + 20480);
    { const int r16 = lane & 15, q = lane >> 4; const u32x4 z4 = {0u, 0u, 0u, 0u}; const f32x4 zero = {0.f, 0.f, 0.f, 0.f};
#pragma unroll
      for (int tt = 0; tt < 4; ++tt) { const LAS float* lr = lrs + (16 * tt + r16) * 32 + 8 * q; const f32x4 l0 = *(const LAS f32x4*)lr, l1 = *(const LAS f32x4*)(lr + 4);
          u32x4 bu; bu.x = pkbf(l0.x, l0.y); bu.y = pkbf(l0.z, l0.w); bu.z = pkbf(l1.x, l1.y); bu.w = pkbf(l1.z, l1.w);
          const u32x4 bfw = q < 2 ? bu : z4, bbw = q < 2 ? z4 : bu;
          const f32x4 zf = MFMA16(Aop, __builtin_bit_cast(bf16x8, bfw), zero), zb = MFMA16(Aop, __builtin_bit_cast(bf16x8, bbw), zero);
          *(LAS f32x4*)(Zs + (size_t)(16 * tt + r16) * 132 + 16 * w + 4 * q) = zf; *(LAS f32x4*)(Zs + (size_t)(64 + 16 * tt + r16) * 132 + 16 * w + 4 * q) = zb; } }
    __syncthreads();
    float g[2][8][2];
#pragma unroll
    for (int dir = 0; dir < 2; ++dir)
#pragma unroll
        for (int i = 0; i < 8; ++i) { const f32x2v z = *(const LAS f32x2v*)(Zs + (size_t)(dir * 64 + 8 * w + i) * 132 + d);
            g[dir][i][0] = logsig16(z.x + bgv[dir][0]); g[dir][i][1] = logsig16(z.y + bgv[dir][1]); }
#pragma unroll
    for (int dd = 0; dd < 2; ++dd) {
        float s = 0.f;
#pragma unroll
        for (int i = 0; i < 8; ++i) { s += g[0][i][dd]; g[0][i][dd] = s; }
        tots[(0 * 8 + w) * 128 + d + dd] = s;
        s = 0.f;
#pragma unroll
        for (int i = 7; i >= 0; --i) { s += g[1][i][dd]; g[1][i][dd] = s; }
        tots[(1 * 8 + w) * 128 + d + dd] = s;
    }
    if (w == 4) { gref[d] = g[0][0][0]; gref[d + 1] = g[0][0][1]; }
    if (w == 3) { gref[128 + d] = g[1][7][0]; gref[128 + d + 1] = g[1][7][1]; }
    __syncthreads();
    float pre[2][2], bref[2][2], ball[2][2];
#pragma unroll
    for (int dd = 0; dd < 2; ++dd) {
        float pf = 0.f, af = 0.f, rf = 0.f, pb = 0.f, ab = 0.f, rb = 0.f;
#pragma unroll
        for (int ww = 0; ww < 8; ++ww) { const float tf = tots[ww * 128 + d + dd], tbk = tots[(8 + ww) * 128 + d + dd];
            af += tf; ab += tbk; if (ww < w) pf += tf; if (ww > w) pb += tbk; if (ww < 4) rf += tf; if (ww > 3) rb += tbk; }
        pre[0][dd] = pf; pre[1][dd] = pb; ball[0][dd] = af; ball[1][dd] = ab;
        bref[0][dd] = rf + gref[d + dd]; bref[1][dd] = rb + gref[128 + d + dd];
    }
    if (w == 0) {
#pragma unroll
        for (int dir = 0; dir < 2; ++dir) { float* ev = c.EV + (size_t)((((b * 4 + h) * 2 + dir) * 64) + n) * 256;
            f32x2v e1; e1.x = __builtin_amdgcn_exp2f(bref[dir][0]); e1.y = __builtin_amdgcn_exp2f(bref[dir][1]);
            f32x2v e2; e2.x = __builtin_amdgcn_exp2f(ball[dir][0] - bref[dir][0]); e2.y = __builtin_amdgcn_exp2f(ball[dir][1] - bref[dir][1]);
            *(f32x2v*)(ev + d) = e1; *(f32x2v*)(ev + 128 + d) = e2; }
    }
    const size_t hb = ((size_t)(b * 4 + h) * SEQ + (size_t)n * CH) * 128 + d;
#pragma unroll
    for (int i = 0; i < 8; ++i) { const size_t off = hb + (size_t)(8 * w + i) * 128;
        const float q0 = bflo(qu[i]), q1 = bfhi(qu[i]), k0 = bflo(ku[i]), k1 = bfhi(ku[i]);
#pragma unroll
        for (int dir = 0; dir < 2; ++dir) {
            const float e0 = __builtin_amdgcn_exp2f(pre[dir][0] + g[dir][i][0] - bref[dir][0]), e1 = __builtin_amdgcn_exp2f(pre[dir][1] + g[dir][i][1] - bref[dir][1]);
            const float r0 = __builtin_amdgcn_rcpf(e0), r1 = __builtin_amdgcn_rcpf(e1);
            *(unsigned*)((dir ? c.QAB : c.QAF) + off) = pkbf(q0 * e0, q1 * e1);
            *(unsigned*)((dir ? c.KAB : c.KAF) + off) = pkbf(k0 * r0, k1 * r1); }
    }
}
__device__ __forceinline__ void unpack8(const u32x4 u, float (&f)[8]) { f[0] = bflo(u.x); f[1] = bfhi(u.x); f[2] = bflo(u.y); f[3] = bfhi(u.y); f[4] = bflo(u.z); f[5] = bfhi(u.z); f[6] = bflo(u.w); f[7] = bfhi(u.w); }
__device__ __forceinline__ void conv_item(const Ctx& c, int cb) {
    const int tid = threadIdx.x, ch = (tid & 127) * 8, tq = tid >> 7;
    float w0[8], w1[8], w2[8], bb[8];
#pragma unroll
    for (int e = 0; e < 8; ++e) { w0[e] = c.conv_w[ch + e]; w1[e] = c.conv_w[1024 + ch + e]; w2[e] = c.conv_w[2048 + ch + e]; bb[e] = c.conv_b[ch + e]; }
    const size_t t0 = (size_t)cb * 64 + 16 * tq; const int pos0 = (int)(t0 % SEQ);
    const u32x4 zero4 = {0u, 0u, 0u, 0u};
    float prev[8], cur[8];
    { u32x4 up = *(const u32x4*)(c.U + (pos0 > 0 ? t0 - 1 : t0) * 1024 + ch); if (pos0 == 0) up = zero4; unpack8(up, prev); }
    unpack8(*(const u32x4*)(c.U + t0 * 1024 + ch), cur);
#pragma unroll
    for (int hb = 0; hb < 2; ++hb) {
        u32x4 un[8], bzr[8];
#pragma unroll
        for (int i = 0; i < 8; ++i) { const size_t t = t0 + 8 * hb + i;
            { const bool inb = (pos0 + 8 * hb + i + 1 < SEQ); un[i] = *(const u32x4*)(c.U + (inb ? t + 1 : t) * 1024 + ch); if (!inb) un[i] = zero4; }
            bzr[i] = *(const u32x4*)(c.BZ + t * 1024 + ch); }
#pragma unroll
        for (int i = 0; i < 8; ++i) { const size_t t = t0 + 8 * hb + i; float nxt[8], bz[8], y[8];
            unpack8(un[i], nxt); unpack8(bzr[i], bz);
#pragma unroll
            for (int e = 0; e < 8; ++e) { y[e] = bz[e] * (w0[e] * prev[e] + w1[e] * cur[e] + w2[e] * nxt[e] + bb[e]); prev[e] = cur[e]; cur[e] = nxt[e]; }
            u32x4 o; o.x = pkbf(y[0], y[1]); o.y = pkbf(y[2], y[3]); o.z = pkbf(y[4], y[5]); o.w = pkbf(y[6], y[7]);
            *(u32x4*)(c.Y + t * 2048 + 1024 + ch) = o; }
    }
}
__device__ __forceinline__ void phase2(const Ctx& c, LAS unsigned char* lds) {
    {
        const int G4 = (int)gridDim.x >> 2, h = (int)blockIdx.x & 3; int p = (int)blockIdx.x >> 2;
        if ((int)blockIdx.x < 4 * G4) {
            const int col = h * 128 + 2 * (threadIdx.x & 63);
            float bgv[2][2];
#pragma unroll
            for (int dir = 0; dir < 2; ++dir) { const float* bg = dir ? c.bgb : c.bgf; const f32x2v bb = *(const f32x2v*)(bg + col); bgv[dir][0] = bb.x; bgv[dir][1] = bb.y; }
            bf16x8 Aop;
            { const int lane_ = threadIdx.x & 63, w_ = __builtin_amdgcn_readfirstlane(threadIdx.x >> 6), q_ = lane_ >> 4; const float* Wsrc = q_ < 2 ? c.wgf : c.wgb;
              const int dcol = h * 128 + 16 * w_ + (lane_ & 15), r0 = 8 * (q_ & 1); float t_[8];
#pragma unroll
              for (int j = 0; j < 8; ++j) t_[j] = Wsrc[(r0 + j) * 512 + dcol];
              u32x4 au; au.x = pkbf(t_[0], t_[1]); au.y = pkbf(t_[2], t_[3]); au.z = pkbf(t_[4], t_[5]); au.w = pkbf(t_[6], t_[7]); Aop = __builtin_bit_cast(bf16x8, au); }
            f32x4 lrv = (f32x4){0.f, 0.f, 0.f, 0.f};
            if (p < 512) { const int n0 = p & 63, b0 = p >> 6; lrv = *(const f32x4*)(c.LR + ((size_t)b0 * SEQ + (size_t)n0 * CH) * 32 + threadIdx.x * 4); }
            for (; p < 512; p += G4) { const int pn = p + G4; gla_pre_item(c, p * 4 + h, pn < 512 ? pn * 4 + h : -1, lrv, Aop, bgv, lds); }
        }
    }
}

constexpr int L_SET = 44032, L_QA = 0, L_KA = 17408, L_V = 34816, L_ATT = 88064  , L_XT = 106496, L_EV = 123904  , L_CV = 125952;
typedef short s16x4 __attribute__((ext_vector_type(4)));
typedef short v4i16_t __attribute__((ext_vector_type(4)));
__device__ __forceinline__ bf16x8 lds16(LAS unsigned char* p) { return *(const LAS bf16x8*)p; }
__device__ __forceinline__ bf16x8 lds_tr(LAS unsigned char* p0, int pitch4) {
    const s16x4 lo = __builtin_bit_cast(s16x4, __builtin_amdgcn_ds_read_tr16_b64_v4i16((LAS v4i16_t*)p0));
    const s16x4 hi = __builtin_bit_cast(s16x4, __builtin_amdgcn_ds_read_tr16_b64_v4i16((LAS v4i16_t*)(p0 + pitch4)));
    return __builtin_shufflevector(lo, hi, 0, 1, 2, 3, 4, 5, 6, 7);
}
#define LDS_BAR() do { asm volatile("s_waitcnt lgkmcnt(0)" ::: "memory"); __builtin_amdgcn_s_barrier(); asm volatile("" ::: "memory"); } while (0)
struct ScanStage { u32x4 q[2], k[2], v, ev, cu0, cu1, cu2, cbz; };
__device__ __forceinline__ void scan_item(const Ctx& c, int item, LAS unsigned char* lds) {
    const int dvs = item & 3, dir = (item >> 2) & 1, h = (item >> 3) & 3, b = item >> 5;
    const int tid = threadIdx.x, lane = tid & 63, w = __builtin_amdgcn_readfirstlane(tid >> 6), r = lane & 15, q = lane >> 4;
    const bf16_t* QA = (dir ? c.QAB : c.QAF) + (size_t)(b * 4 + h) * SEQ * 128;
    const bf16_t* KA = (dir ? c.KAB : c.KAF) + (size_t)(b * 4 + h) * SEQ * 128;
    const bf16_t* Vh = c.V + (size_t)((b * 4 + h) * 4 + dvs) * SEQ * 64;
    bf16_t* O = dir ? c.Y + (size_t)b * SEQ * 2048 + h * 256 + dvs * 64 : c.OF + (size_t)((b * 4 + h) * 4 + dvs) * SEQ * 64;
    const int opitch = dir ? 2048 : 64;
    const float* EV = c.EV + (size_t)(((b * 4 + h) * 2 + dir) * 64) * 256;
    f32x4 T[4];
#pragma unroll
    for (int i = 0; i < 4; ++i) T[i] = (f32x4){0.f, 0.f, 0.f, 0.f};
    ScanStage R0, R1;
    const int cch = (tid & 127) * 8; const size_t ctok0 = (size_t)item * 128 + (tid >> 7);
    f32x4 cw0[2], cw1[2], cw2[2], cwb[2];
#pragma unroll
    for (int e = 0; e < 2; ++e) { cw0[e] = *(const f32x4*)(c.conv_w + cch + 4 * e); cw1[e] = *(const f32x4*)(c.conv_w + 1024 + cch + 4 * e); cw2[e] = *(const f32x4*)(c.conv_w + 2048 + cch + 4 * e); cwb[e] = *(const f32x4*)(c.conv_b + cch + 4 * e); }
    u32x2* const dummy = (u32x2*)((unsigned char*)c.ssq + 480 * MiB) + (size_t)blockIdx.x * 512 + tid;
#define SCAN_LOAD(R, ss, CV) do { const int nn_ = dir ? 63 - (ss) : (ss); \
        (R).q[0] = *(const u32x4*)(QA + (size_t)nn_ * 8192 + tid * 8); (R).q[1] = *(const u32x4*)(QA + (size_t)nn_ * 8192 + 4096 + tid * 8); \
        (R).k[0] = *(const u32x4*)(KA + (size_t)nn_ * 8192 + tid * 8); (R).k[1] = *(const u32x4*)(KA + (size_t)nn_ * 8192 + 4096 + tid * 8); \
        (R).v = *(const u32x4*)(Vh + (size_t)nn_ * 4096 + tid * 8); \
        (R).ev = *(const u32x4*)(EV + (size_t)nn_ * 256 + (tid & 63) * 4); \
        if (CV) { const size_t t_ = ctok0 + 4 * (((ss) - 1) >> 1); const int p_ = (int)(t_ & (SEQ - 1)); \
          (R).cu0 = *(const u32x4*)(c.U + (p_ > 0 ? t_ - 1 : t_) * 1024 + cch); (R).cu1 = *(const u32x4*)(c.U + t_ * 1024 + cch); \
          (R).cu2 = *(const u32x4*)(c.U + (p_ + 1 < SEQ ? t_ + 1 : t_) * 1024 + cch); (R).cbz = *(const u32x4*)(c.BZ + t_ * 1024 + cch); } } while (0)
#define SCAN_PUT(R, set, CV) do { LAS unsigned char* sb_ = lds + (set) * L_SET; \
        *(LAS u32x4*)(sb_ + L_QA + (tid >> 4) * 272 + (tid & 15) * 16) = (R).q[0]; *(LAS u32x4*)(sb_ + L_QA + (32 + (tid >> 4)) * 272 + (tid & 15) * 16) = (R).q[1]; \
        *(LAS u32x4*)(sb_ + L_KA + (tid >> 4) * 272 + (tid & 15) * 16) = (R).k[0]; *(LAS u32x4*)(sb_ + L_KA + (32 + (tid >> 4)) * 272 + (tid & 15) * 16) = (R).k[1]; \
        *(LAS u32x4*)(sb_ + L_V + (tid >> 3) * 144 + (tid & 7) * 16) = (R).v; \
        *(LAS u32x4*)(lds + L_EV + (set) * 1024 + (tid & 63) * 16) = (R).ev;     \
        if (CV) { *(LAS u32x4*)(lds + L_CV + tid * 16) = (R).cu0; *(LAS u32x4*)(lds + L_CV + 8192 + tid * 16) = (R).cu1; *(LAS u32x4*)(lds + L_CV + 16384 + tid * 16) = (R).cu2; *(LAS u32x4*)(lds + L_CV + 24576 + tid * 16) = (R).cbz; } } while (0)
    const int jt = w & 3, tt0 = 2 * (w >> 2), vt = w & 3;
    const int rowoff272 = r * 272 + q * 16, rowoff144 = r * 144 + q * 16;
    const int troff272 = (8 * q + ((lane >> 2) & 3)) * 272 + (lane & 3) * 8, troff144 = (8 * q + ((lane >> 2) & 3)) * 144 + (lane & 3) * 8;
    f32x4 e2prev = (f32x4){1.f, 1.f, 1.f, 1.f};
#define SCAN_ATT(setx, abuf) do { LAS unsigned char* sx_ = lds + (setx) * L_SET; LAS unsigned char* ab_ = lds + L_ATT + (abuf) * 9216; \
        f32x4 c0 = (f32x4){0.f, 0.f, 0.f, 0.f}, c1 = c0; \
        _Pragma("unroll") for (int ks = 0; ks < 4; ++ks) { \
            const bf16x8 a = lds16(sx_ + L_KA + (16 * jt) * 272 + rowoff272 + ks * 64); \
            const bf16x8 b0 = lds16(sx_ + L_QA + (16 * tt0) * 272 + rowoff272 + ks * 64); \
            const bf16x8 b1 = lds16(sx_ + L_QA + (16 * (tt0 + 1)) * 272 + rowoff272 + ks * 64); \
            c0 = MFMA16(a, b0, c0); c1 = MFMA16(a, b1, c1); } \
        const int j0 = 16 * jt + 4 * q; \
        _Pragma("unroll") for (int half = 0; half < 2; ++half) { const int t = 16 * (tt0 + half) + r; const f32x4 cc = half ? c1 : c0; float v[4]; \
            _Pragma("unroll") for (int i = 0; i < 4; ++i) { const int j = j0 + i; const bool keep = dir ? (j > t) : (j <= t); v[i] = keep ? cc[i] : 0.f; } \
            u32x2 o; o.x = pkbf(v[0], v[1]); o.y = pkbf(v[2], v[3]); \
            *(LAS u32x2*)(ab_ + t * 144 + j0 * 2) = o; } } while (0)
#define SCAN_CONV(pi) do { const size_t ct_ = ctok0 + 4 * (pi); const int cpos_ = (int)(ct_ & (SEQ - 1)); \
        u32x4 cup_ = *(const LAS u32x4*)(lds + L_CV + tid * 16); const u32x4 cuc_ = *(const LAS u32x4*)(lds + L_CV + 8192 + tid * 16); \
        u32x4 cun_ = *(const LAS u32x4*)(lds + L_CV + 16384 + tid * 16); const u32x4 cbz_ = *(const LAS u32x4*)(lds + L_CV + 24576 + tid * 16); \
        if (cpos_ == 0) cup_ = (u32x4){0u, 0u, 0u, 0u}; if (cpos_ + 1 >= SEQ) cun_ = (u32x4){0u, 0u, 0u, 0u}; \
        float up_[8], uc_[8], un_[8], bz_[8]; unpack8(cup_, up_); unpack8(cuc_, uc_); unpack8(cun_, un_); unpack8(cbz_, bz_); \
        float y_[8]; \
        _Pragma("unroll") for (int e = 0; e < 8; ++e) y_[e] = bz_[e] * (cw0[e >> 2][e & 3] * up_[e] + cw1[e >> 2][e & 3] * uc_[e] + cw2[e >> 2][e & 3] * un_[e] + cwb[e >> 2][e & 3]); \
        u32x4 yo; yo.x = pkbf(y_[0], y_[1]); yo.y = pkbf(y_[2], y_[3]); yo.z = pkbf(y_[4], y_[5]); yo.w = pkbf(y_[6], y_[7]); \
        *(u32x4*)(c.Y + ct_ * 2048 + 1024 + cch) = yo; } while (0)
    SCAN_LOAD(R0, 0, 0); SCAN_PUT(R0, 0, 0);
    SCAN_LOAD(R0, 1, 1); SCAN_LOAD(R1, 2, 0);
    LDS_BAR();
    SCAN_ATT(0, 0);
#pragma unroll
    for (int k = 0; k < 6; ++k) { asm volatile("" ::: "memory"); *dummy = (u32x2){0u, 0u}; }
    asm volatile("s_waitcnt lgkmcnt(0)" ::: "memory");
#define SCAN_STEP(s, R, CV) do { \
        LAS unsigned char* sb = lds + ((s) & 1) * L_SET; const int n = dir ? 63 - (s) : (s); \
        SCAN_PUT(R, ((s) + 1) & 1, CV); \
        SCAN_LOAD(R, ((s) + 3 < 64 ? (s) + 3 : 63), CV);   \
        { const f32x4 e1v_ = *(const LAS f32x4*)(lds + L_EV + ((s) & 1) * 1024 + (16 * w + 4 * q) * 4), e2v_ = *(const LAS f32x4*)(lds + L_EV + ((s) & 1) * 1024 + 512 + (16 * w + 4 * q) * 4); \
          const f32x4 fcur = e1v_ * e2prev; e2prev = e2v_; \
          _Pragma("unroll") for (int v2 = 0; v2 < 4; ++v2) { T[v2] = T[v2] * fcur; \
              u32x2 o; o.x = pkbf(T[v2][0], T[v2][1]); o.y = pkbf(T[v2][2], T[v2][3]); \
              *(LAS u32x2*)(lds + L_XT + (16 * v2 + r) * 272 + (16 * w + 4 * q) * 2) = o; } } \
        LDS_BAR(); \
        { LAS unsigned char* ab = lds + L_ATT + ((s) & 1) * 9216; \
            _Pragma("unroll") for (int ks = 0; ks < 2; ++ks) { \
                const bf16x8 a = lds_tr(sb + L_KA + (32 * ks) * 272 + troff272 + (16 * w) * 2, 4 * 272); \
                _Pragma("unroll") for (int v2 = 0; v2 < 4; ++v2) { const bf16x8 bb = lds_tr(sb + L_V + (32 * ks) * 144 + troff144 + (16 * v2) * 2, 4 * 144); T[v2] = MFMA16(a, bb, T[v2]); } } \
            f32x4 o0 = (f32x4){0.f, 0.f, 0.f, 0.f}, o1 = o0; \
            _Pragma("unroll") for (int ks = 0; ks < 2; ++ks) { \
                const bf16x8 a = lds_tr(sb + L_V + (32 * ks) * 144 + troff144 + (16 * vt) * 2, 4 * 144); \
                const bf16x8 b0 = lds16(ab + (16 * tt0) * 144 + rowoff144 + ks * 64); \
                const bf16x8 b1 = lds16(ab + (16 * (tt0 + 1)) * 144 + rowoff144 + ks * 64); \
                o0 = MFMA16(a, b0, o0); o1 = MFMA16(a, b1, o1); } \
            _Pragma("unroll") for (int ks = 0; ks < 4; ++ks) { \
                const bf16x8 a = lds16(lds + L_XT + (16 * vt) * 272 + rowoff272 + ks * 64); \
                const bf16x8 b0 = lds16(sb + L_QA + (16 * tt0) * 272 + rowoff272 + ks * 64); \
                const bf16x8 b1 = lds16(sb + L_QA + (16 * (tt0 + 1)) * 272 + rowoff272 + ks * 64); \
                o0 = MFMA16(a, b0, o0); o1 = MFMA16(a, b1, o1); } \
            u32x2 p0, p1; p0.x = pkbf(o0[0], o0[1]); p0.y = pkbf(o0[2], o0[3]); p1.x = pkbf(o1[0], o1[1]); p1.y = pkbf(o1[2], o1[3]); \
            *(u32x2*)(O + ((size_t)n * 64 + 16 * tt0 + r) * opitch + 16 * vt + 4 * q) = p0; \
            *(u32x2*)(O + ((size_t)n * 64 + 16 * (tt0 + 1) + r) * opitch + 16 * vt + 4 * q) = p1; \
        } \
        SCAN_ATT(((s) + 1) & 1, ((s) + 1) & 1); \
        if (CV) SCAN_CONV((s) >> 1); \
        LDS_BAR(); \
    } while (0)
    for (int s2 = 0; s2 < 64; s2 += 2) { SCAN_STEP(s2, R0, 1); SCAN_STEP(s2 + 1, R1, 0); }
#undef SCAN_ATT
#undef SCAN_CONV
#undef SCAN_STEP
#undef SCAN_LOAD
#undef SCAN_PUT
}
__device__ __forceinline__ void phase3(const Ctx& c, LAS unsigned char* lds) {
    const int G = gridDim.x, bx = blockIdx.x;
    const int vcu = (G % 8 == 0) ? (bx % 8) * (G / 8) + bx / 8 : bx;
    for (int it = vcu; it < 256; it += G) scan_item(c, it, lds);
}

__device__ __forceinline__ void phase4(const Ctx& c) {
    const int tid = threadIdx.x, lane = tid & 63, w = tid >> 6;
    const int gw = blockIdx.x * 8 + w, NGW = gridDim.x * 8;
    const int hh = lane >> 4, dvs = (lane >> 2) & 3, kk = lane & 3;
    float gn[16];
#pragma unroll
    for (int e = 0; e < 16; ++e) gn[e] = c.gng[(lane & 15) * 16 + e];
    for (int m0 = gw * 2; m0 < M; m0 += NGW * 2) {
        u32x4 ra[2][2], rb[2][2], rz[2][2];
#pragma unroll
        for (int rr = 0; rr < 2; ++rr) { const int m = m0 + rr; const int bb = m >> 12, ss = m & 4095;
            const size_t ooff = ((size_t)(((bb * 4 + hh) * 4 + dvs) * 4096 + ss)) * 64 + kk * 16; const size_t zoff = (size_t)m * 1024 + lane * 16;
            ra[rr][0] = __builtin_nontemporal_load((const u32x4*)(c.OF + ooff)); ra[rr][1] = __builtin_nontemporal_load((const u32x4*)(c.OF + ooff + 8));
            rb[rr][0] = *(const u32x4*)(c.Y + (size_t)m * 2048 + lane * 16); rb[rr][1] = *(const u32x4*)(c.Y + (size_t)m * 2048 + lane * 16 + 8);
            rz[rr][0] = __builtin_nontemporal_load((const u32x4*)(c.ZA + zoff)); rz[rr][1] = __builtin_nontemporal_load((const u32x4*)(c.ZA + zoff + 8)); }
#pragma unroll
        for (int rr = 0; rr < 2; ++rr) { const int m = m0 + rr;
            float a[16], bq[16], z[16];
            { float t[8]; unpack8(ra[rr][0], t); for (int e = 0; e < 8; ++e) a[e] = t[e]; unpack8(ra[rr][1], t); for (int e = 0; e < 8; ++e) a[8 + e] = t[e]; }
            { float t[8]; unpack8(rb[rr][0], t); for (int e = 0; e < 8; ++e) bq[e] = t[e]; unpack8(rb[rr][1], t); for (int e = 0; e < 8; ++e) bq[8 + e] = t[e]; }
            { float t[8]; unpack8(rz[rr][0], t); for (int e = 0; e < 8; ++e) z[e] = t[e]; unpack8(rz[rr][1], t); for (int e = 0; e < 8; ++e) z[8 + e] = t[e]; }
            float s = 0.f;
#pragma unroll
            for (int e = 0; e < 16; ++e) { a[e] += bq[e]; s += a[e] * a[e]; }
#pragma unroll
            for (int o = 1; o < 16; o <<= 1) s += __shfl_xor(s, o);
            const float rs = 1.0f / sqrtf(s * (1.0f / 256.0f) + EPS);
            float y[16];
#pragma unroll
            for (int e = 0; e < 16; ++e) y[e] = a[e] * rs * gn[e] * silu_f(z[e]);
            u32x4 o0, o1; o0.x = pkbf(y[0], y[1]); o0.y = pkbf(y[2], y[3]); o0.z = pkbf(y[4], y[5]); o0.w = pkbf(y[6], y[7]);
            o1.x = pkbf(y[8], y[9]); o1.y = pkbf(y[10], y[11]); o1.z = pkbf(y[12], y[13]); o1.w = pkbf(y[14], y[15]);
            *(u32x4*)(c.Y + (size_t)m * 2048 + lane * 16) = o0; *(u32x4*)(c.Y + (size_t)m * 2048 + lane * 16 + 8) = o1; }
    }
}

struct EpiOutNorm {
    static constexpr bool PERM = false, AFTER_DRAIN = false;
    const float* X; float* O; unsigned char* ws; const float* fg;
    __device__ __forceinline__ void operator()(f32x4 (&acc)[2][2][4][2], const pg8::Unit& u, int wr, int wc, int fr, int fq) const {
        float* const ssq = (float*)(ws + WS_SSQ); unsigned* const cnt = (unsigned*)(ws + WS_SSQ + 256 * 1024);
        const int row0 = u.pm * 256 + wr * 64 + fr, col0 = u.pn * 256 + wc * 32 + 4 * fq;
#pragma unroll
        for (int ai = 0; ai < 2; ++ai)
#pragma unroll
            for (int m = 0; m < 4; ++m) { const int row = row0 + ai * 128 + m * 16; const size_t off = (size_t)row * 1024 + col0; float s = 0.f;
#pragma unroll
                for (int bj = 0; bj < 2; ++bj)
#pragma unroll
                    for (int n = 0; n < 2; ++n) { const f32x4 xv = __builtin_nontemporal_load((const f32x4*)(X + off + bj * 128 + n * 16)); const f32x4 o = xv + acc[ai][bj][m][n];
                        acc[ai][bj][m][n] = o; s += (o[0] * o[0] + o[1] * o[1]) + (o[2] * o[2] + o[3] * o[3]); }
                s += __shfl_xor(s, 16); s += __shfl_xor(s, 32);
                if (fq == 0) atomicAdd(ssq + row, s);
                if (m & 1) asm volatile("" ::: "memory"); }
        asm volatile("s_waitcnt vmcnt(0)" ::: "memory");
        unsigned* cw = cnt + (u.pm * 2 + wr) * 64;
        if ((threadIdx.x & 63) == 0) __hip_atomic_fetch_add(cw, 1u, __ATOMIC_RELAXED, __HIP_MEMORY_SCOPE_AGENT);
        unsigned polls = 0;
        while ((unsigned)__builtin_amdgcn_readfirstlane(__hip_atomic_load(cw, __ATOMIC_RELAXED, __HIP_MEMORY_SCOPE_AGENT)) < 16u) { __builtin_amdgcn_s_sleep(2); if (++polls > (1u << 22)) break; }
        asm volatile("" ::: "memory");
#pragma unroll
        for (int ai = 0; ai < 2; ++ai)
#pragma unroll
            for (int m = 0; m < 4; ++m) { const int row = row0 + ai * 128 + m * 16; const size_t off = (size_t)row * 1024 + col0;
                const float rs = 1.0f / sqrtf(__hip_atomic_load(ssq + row, __ATOMIC_RELAXED, __HIP_MEMORY_SCOPE_AGENT) * (1.0f / DM) + EPS);
#pragma unroll
                for (int bj = 0; bj < 2; ++bj)
#pragma unroll
                    for (int n = 0; n < 2; ++n) __builtin_nontemporal_store(acc[ai][bj][m][n] * rs * *(const f32x4*)(fg + col0 + bj * 128 + n * 16), (f32x4*)(O + off + bj * 128 + n * 16));
                asm volatile("" ::: "memory"); }
    }
};
__device__ __forceinline__ void lr_phase(const bf16_t* XB, const bf16_t* WLR  , float* LR, LAS unsigned char* lds) {
    const int tid = threadIdx.x, lane = tid & 63, w = tid >> 6, r = lane & 15, q = lane >> 4;
    constexpr int WP = 2064;
#pragma unroll
    for (int i = 0; i < 8; ++i) { const int p = tid + 512 * i, n = p >> 7, c16 = p & 127;
        *(LAS u32x4*)(lds + n * WP + c16 * 16) = *(const u32x4*)(WLR + (size_t)n * DM + c16 * 8); }
    __syncthreads();
    const int NGW = gridDim.x * 8;
    for (int task = blockIdx.x * 8 + w; task < M / 16; task += NGW) {
        const bf16_t* arow = XB + (size_t)(task * 16 + r) * DM + 8 * q;
        f32x4 c0 = (f32x4){0.f, 0.f, 0.f, 0.f}, c1 = c0;
#pragma unroll
        for (int hf = 0; hf < 2; ++hf) {
            bf16x8 a[16];
#pragma unroll
            for (int ks = 0; ks < 16; ++ks) a[ks] = *(const bf16x8*)(arow + 32 * (16 * hf + ks));
#pragma unroll
            for (int ks = 0; ks < 16; ++ks) { const int kk = 16 * hf + ks;
                const bf16x8 b0 = *(const LAS bf16x8*)(lds + r * WP + (32 * kk + 8 * q) * 2), b1 = *(const LAS bf16x8*)(lds + (16 + r) * WP + (32 * kk + 8 * q) * 2);
                c0 = MFMA16(b0, a[ks], c0); c1 = MFMA16(b1, a[ks], c1); }
            asm volatile("" ::: "memory");
        }
        float* o = LR + (size_t)(task * 16 + r) * 32 + 4 * q;
        *(f32x4*)o = c0; *(f32x4*)(o + 16) = c1;
    }
    __syncthreads();
}

#define XB_TMO      128
#define XB_XCNT(j)  (256  + 64 * (j))
#define XB_XSUB(j)  (1280 + 64 * (j))
#define XB_XGEN(j)  (2304 + 64 * (j))
#define XB_TOP      3328
#define XB_TOPGEN   3392
#define XCD_BAR_WORDS 3456
#define XB_SPIN_CAP (1u << 18)

__device__ __forceinline__ unsigned xb_ld(unsigned* p)              { return __hip_atomic_load(p, __ATOMIC_RELAXED, __HIP_MEMORY_SCOPE_AGENT); }
__device__ __forceinline__ unsigned xb_add(unsigned* p, unsigned v) { return __hip_atomic_fetch_add(p, v, __ATOMIC_RELAXED, __HIP_MEMORY_SCOPE_AGENT); }
__device__ __forceinline__ unsigned xb_xcc_id() { return (unsigned)__builtin_amdgcn_s_getreg((3 << 11) | 20) & 0xFu; }
#define XB_SPIN(cond, bar) do { unsigned _sp = 0; while (cond) { __builtin_amdgcn_s_sleep(1); \
    if ((++_sp & 255u) == 0u) { if (xb_ld(&(bar)[XB_TMO])) break; if (_sp > XB_SPIN_CAP) { atomicAdd(&(bar)[XB_TMO], 1u); break; } } } } while (0)

struct XcdBarrier {
    unsigned* bar; unsigned x;
    volatile LAS unsigned* st;
};

__device__ __forceinline__ XcdBarrier xcd_barrier_post(unsigned* bar, volatile LAS unsigned* st) {
    XcdBarrier b; b.bar = bar; b.x = xb_xcc_id(); b.st = st;
    if (threadIdx.x == 0) (void)xb_add(&bar[XB_XCNT(b.x)], 1u);
    return b;
}
__device__ __forceinline__ void xcd_barrier_complete(unsigned* bar, unsigned x, unsigned& nloc, unsigned& nx) {
    const unsigned G = gridDim.x * gridDim.y * gridDim.z;
    unsigned sum, cnt, mine, sp = 0u;
    for (;;) {
        sum = 0u; cnt = 0u; mine = 0u;
#pragma unroll
        for (unsigned j = 0; j < 16; ++j) { const unsigned c = xb_ld(&bar[XB_XCNT(j)]); sum += c; cnt += (c > 0u) ? 1u : 0u; mine = (j == x) ? c : mine; }
        if (sum == G) break;
        __builtin_amdgcn_s_sleep(1);
        if ((++sp & 255u) == 0u) { if (xb_ld(&bar[XB_TMO])) break; if (sp > XB_SPIN_CAP) { atomicAdd(&bar[XB_TMO], 1u); break; } }
    }
    nloc = mine > 0u ? mine : 1u; nx = cnt > 0u ? cnt : 1u;
}

__device__ __forceinline__ void xcd_barrier(const XcdBarrier& b) {
    asm volatile("s_waitcnt vmcnt(0)" ::: "memory");
    __syncthreads();
    if (threadIdx.x == 0) {
        unsigned* bar = b.bar;
        __builtin_amdgcn_s_waitcnt(0);
        unsigned nloc = b.st[0], nx = b.st[1];
        if (nloc == 0u) { xcd_barrier_complete(bar, b.x, nloc, nx); b.st[0] = nloc; b.st[1] = nx; }
        const unsigned old = xb_add(&bar[XB_XSUB(b.x)], 1u);
        const unsigned gen = old / nloc;
        if (old + 1u == (gen + 1u) * nloc) {
            __builtin_amdgcn_fence(__ATOMIC_RELEASE, "agent");
            asm volatile("s_waitcnt vmcnt(0)" ::: "memory");
            const unsigned og = xb_add(&bar[XB_TOP], 1u);
            const unsigned tg = og / nx;
            if (og + 1u == (tg + 1u) * nx) xb_add(&bar[XB_TOPGEN], 1u);
            else XB_SPIN(xb_ld(&bar[XB_TOPGEN]) == tg, bar);
            __builtin_amdgcn_fence(__ATOMIC_ACQUIRE, "agent");
            xb_add(&bar[XB_XGEN(b.x)], 1u);
            asm volatile("s_waitcnt vmcnt(0)" ::: "memory");
        } else {
            XB_SPIN(xb_ld(&bar[XB_XGEN(b.x)]) == gen, bar);
            __builtin_amdgcn_fence(__ATOMIC_ACQUIRE, "agent");
            asm volatile("s_waitcnt vmcnt(0)" ::: "memory");
        }
    }
    __syncthreads();
}


struct Args { const float* in[12]; float* out; unsigned char* ws; int ph_lo, ph_hi; };
typedef const __attribute__((address_space(4))) Args* KArgs;
__device__ __forceinline__ KArgs kargs() { auto p = __builtin_amdgcn_kernarg_segment_ptr(); asm volatile("" : "+s"(p)); return (KArgs)p; }
__device__ __forceinline__ Ctx make_ctx(KArgs a) {
    Ctx c;
    c.x = a->in[0]; c.norm_g = a->in[1]; c.w_in = a->in[2]; c.wgf = a->in[3]; c.bgf = a->in[4]; c.wgb = a->in[5]; c.bgb = a->in[6];
    c.gng = a->in[7]; c.conv_w = a->in[8]; c.conv_b = a->in[9]; c.w_out = a->in[10]; c.final_g = a->in[11];
    c.out = a->out; unsigned char* ws = a->ws;
    c.ssq = (float*)(ws + WS_SSQ); c.cnt = (unsigned*)(ws + WS_SSQ + 256 * 1024); c.LR = (float*)(ws + WS_LR); c.EV = (float*)(ws + WS_EV);
    c.WOT = (bf16_t*)(ws + WS_WOT); c.WINT = (bf16_t*)(ws + WS_WINT); c.V = (bf16_t*)(ws + WS_V); c.ZA = (bf16_t*)(ws + WS_ZA); c.Y = (bf16_t*)(ws + WS_Y);
    c.Q = (bf16_t*)(ws + WS_Q); c.K = (bf16_t*)(ws + WS_K); c.U = (bf16_t*)(ws + WS_U); c.BZ = (bf16_t*)(ws + WS_BZ);
    c.OF = (bf16_t*)(ws + WS_OF); c.OB = (bf16_t*)(ws + WS_OB);
    unsigned char* ob = (unsigned char*)a->out;
    c.XB = (bf16_t*)ob; c.QAF = (bf16_t*)ob; c.KAF = (bf16_t*)(ob + 32 * MiB); c.QAB = (bf16_t*)(ob + 64 * MiB); c.KAB = (bf16_t*)(ob + 96 * MiB);
    return c;
}
__global__ void __launch_bounds__(512, 2) mk_fwd(Args a) {
    extern __shared__ __attribute__((aligned(16))) unsigned char lds_raw[];
    LAS unsigned char* lds = (LAS unsigned char*)lds_raw;
    const int lo = a.ph_lo, hi = a.ph_hi;
#define IN(k) (lo <= (k) && (k) < hi)
    volatile LAS unsigned* barw = (volatile LAS unsigned*)(lds + L_BARW);
    if (threadIdx.x == 0) { barw[0] = 0u; barw[1] = 0u; }
    __syncthreads();
    (void)xcd_barrier_post((unsigned*)(kargs()->ws + WS_BAR), barw);
    if (lo < 0) cg::this_grid().sync();
#define SEAM(k) do { if (IN(k) && IN((k) + 1)) { XcdBarrier xb_; xb_.bar = (unsigned*)(kargs()->ws + WS_BAR); xb_.x = xb_xcc_id(); xb_.st = barw; xcd_barrier(xb_); } } while (0)
    if (IN(0)) { const Ctx c = make_ctx(kargs()); phase0(c, lds); __syncthreads(); }
    SEAM(0);
    if (IN(1)) {
        KArgs ka = kargs(); unsigned char* ws = ka->ws;
        lr_phase((const bf16_t*)ka->out, (const bf16_t*)(ws + WS_WINT) + (size_t)7168 * DM, (float*)(ws + WS_LR), lds);
        pg8::Gemm g{(const bf16_t*)ka->out, (const bf16_t*)(ws + WS_WINT), M, 7168, DM}; pg8::StaticOrder S; S.init(M, 7168, (int)gridDim.x, (int)blockIdx.x);
        EpiIn E{ws};
        pg8::gemm_phase<EpiIn, pg8::StaticOrder, true, true>(lds, g, S, E);
    }
    SEAM(1);
    if (IN(2)) { const Ctx c = make_ctx(kargs()); phase2(c, lds); }
    SEAM(2);
    if (IN(3)) { const Ctx c = make_ctx(kargs()); phase3(c, lds); }
    SEAM(3);
    if (IN(4)) { const Ctx c = make_ctx(kargs()); phase4(c); }
    SEAM(4);
    if (IN(5)) {
        KArgs ka = kargs(); unsigned char* ws = ka->ws;
        pg8::Gemm g{(const bf16_t*)(ws + WS_Y), (const bf16_t*)(ws + WS_WOT), M, DM, MIXW}; pg8::StaticOrder S; S.init(M, DM, (int)gridDim.x, (int)blockIdx.x);
        EpiOutNorm E{ka->in[0], ka->out, ws, ka->in[11]};
        pg8::gemm_phase<EpiOutNorm, pg8::StaticOrder, true, true>(lds, g, S, E);
    }
#undef IN
#undef SEAM
}

extern "C" void kernel_launch(void* const* d_in, const int* in_sizes, int n_in, void* d_out, int out_size, void* d_ws, size_t ws_size, hipStream_t stream) {
    static int grid = 0;
    if (grid == 0) {
        if (n_in != 12 || out_size != M * DM || ws_size < WS_END) { fprintf(stderr, "kernel_launch: unexpected shapes (n_in %d out %d ws %zu)\n", n_in, out_size, ws_size); grid = -1; return; }
        int dev = 0, cus = 0, per_cu = 0;
        (void)hipGetDevice(&dev); (void)hipDeviceGetAttribute(&cus, hipDeviceAttributeMultiprocessorCount, dev);
        (void)hipFuncSetAttribute((const void*)mk_fwd, hipFuncAttributeMaxDynamicSharedMemorySize, LDS_BYTES);
        (void)hipOccupancyMaxActiveBlocksPerMultiprocessor(&per_cu, (const void*)mk_fwd, 512, LDS_BYTES);
        if (per_cu < 1) per_cu = 1;
        (void)hipGetLastError();
        grid = cus * per_cu;
    }
    if (grid < 0) return;
    Args a{};
    for (int i = 0; i < 12; ++i) a.in[i] = (const float*)d_in[i];
    a.out = (float*)d_out; a.ws = (unsigned char*)d_ws;
#if MK_MULTI
    for (int p = 0; p < NPH; ++p) { a.ph_lo = p; a.ph_hi = p + 1; hipLaunchKernelGGL(mk_fwd, dim3(grid), dim3(512), LDS_BYTES, stream, a);
#ifdef PROBE_DUP
        if (((PROBE_DUP >> p) & 1) && p == 5) (void)hipMemsetAsync((char*)d_ws + WS_SSQ, 0, 512 * 1024, stream);
        if ((PROBE_DUP >> p) & 1) hipLaunchKernelGGL(mk_fwd, dim3(grid), dim3(512), LDS_BYTES, stream, a);
#endif
    }
#else
    a.ph_lo = 0; a.ph_hi = NPH;
    (void)hipMemsetAsync((char*)d_ws + WS_BAR, 0, 3456 * 4, stream);
    void* args[] = {&a};
    hipError_t e = hipLaunchCooperativeKernel((const void*)mk_fwd, dim3(grid), dim3(512), args, LDS_BYTES, stream);
    if (e != hipSuccess) fprintf(stderr, "cooperative launch failed: %s (grid %d)\n", hipGetErrorString(e), grid);
#endif
}
```
